# Optimizing an MI355X kernel written in HIP

```python
import math
import jax, jax.numpy as jnp
from jax import lax
import numpy as np

D_MODEL = 1024
BATCH = 8
SEQ = 4096
DEPTH = 1

A_HEADS = 8
A_HEAD_DIM = 64
IDX_HEADS = 8
IDX_DIM = 32
TOPK_MAX = 256
Q_BLOCK = 128
REL_BUCKETS = 32
REL_MAX_DIST = 128
B_HEADS = 4
B_KEY_DIM = 128
B_VAL_DIM = 128
CHUNK = 64
N_EXPERTS = 32
TOP_K = 4
D_FF = 1024
SWIGLU_LIMIT = 7.0
SWIGLU_ALPHA = 1.702
EXPERT_BLOCK = 256
EPS = 1e-6

A_WIDTH = A_HEADS * A_HEAD_DIM
B_WIDTH = B_HEADS * B_VAL_DIM
IN_SPLITS = (A_WIDTH, A_WIDTH, A_WIDTH,
             IDX_HEADS * IDX_DIM, IDX_HEADS, IDX_DIM,
             B_HEADS * B_KEY_DIM, B_HEADS * B_KEY_DIM,
             B_WIDTH, B_WIDTH,
             D_MODEL, D_MODEL)
IN_WIDTH = sum(IN_SPLITS)

kernel_name = "hybrid_dsa_hgrn2_moe_block"


def rmsnorm(x, gain):
    xf = x.astype(jnp.float32)
    y = xf * lax.rsqrt(jnp.mean(xf * xf, axis=-1, keepdims=True) + EPS)
    return (y * gain.astype(jnp.float32)).astype(x.dtype)


def t5_bucket(dist):
    n = jnp.maximum(dist, 0)
    max_exact = REL_BUCKETS // 2
    nf = jnp.maximum(n, 1).astype(jnp.float32)
    large = max_exact + (jnp.log(nf / max_exact) / math.log(REL_MAX_DIST / max_exact)
                         * (REL_BUCKETS - max_exact)).astype(jnp.int32)
    large = jnp.minimum(large, REL_BUCKETS - 1)
    return jnp.where(n < max_exact, n, large)


def dsa_sparse_attention(q, k, v, q_idx, w_idx, k_idx, rel_bias):
    B, S, H, Dh = q.shape
    topk = min(TOPK_MAX, S // 4)
    n_blocks = S // Q_BLOCK
    scale = A_HEAD_DIM ** -0.5
    idx_scale = IDX_DIM ** -0.5
    w_scaled = w_idx.astype(jnp.float32) * (IDX_HEADS ** -0.5)
    key_pos = jnp.arange(S, dtype=jnp.int32)
    bidx = jnp.arange(B)[:, None, None]

    def block(i):
        start = i * Q_BLOCK
        qb = lax.dynamic_slice_in_dim(q, start, Q_BLOCK, axis=1)
        qib = lax.dynamic_slice_in_dim(q_idx, start, Q_BLOCK, axis=1)
        wb = lax.dynamic_slice_in_dim(w_scaled, start, Q_BLOCK, axis=1)
        qpos = start + jnp.arange(Q_BLOCK, dtype=jnp.int32)
        s_h = jnp.einsum('bqhd,bsd->bqhs', qib, k_idx,
                         preferred_element_type=jnp.float32) * idx_scale
        score = jnp.einsum('bqhs,bqh->bqs', jax.nn.relu(s_h), wb)
        causal = key_pos[None, :] <= qpos[:, None]
        score = jnp.where(causal[None], score, -jnp.inf)
        _, sel = lax.top_k(score, topk)
        kg = k[bidx, sel]
        vg = v[bidx, sel]
        logits = jnp.einsum('bqhd,bqkhd->bqhk', qb, kg,
                            preferred_element_type=jnp.float32) * scale
        dist = qpos[None, :, None] - sel
        bias = rel_bias[t5_bucket(dist)].astype(jnp.float32)
        logits = logits + jnp.transpose(bias, (0, 1, 3, 2))
        logits = jnp.where((dist >= 0)[:, :, None, :], logits, -jnp.inf)
        p = jax.nn.softmax(logits, axis=-1).astype(v.dtype)
        return jnp.einsum('bqhk,bqkhd->bqhd', p, vg)

    out = lax.map(block, jnp.arange(n_blocks))
    return jnp.transpose(out, (1, 0, 2, 3, 4)).reshape(B, S, H * Dh)


def hgrn2_chunkwise(q_raw, f_raw, i_in, lb):
    B, S, H, Dk = q_raw.shape
    Dv = i_in.shape[-1]
    n_chunks = S // CHUNK
    f = lb + (1.0 - lb) * jax.nn.sigmoid(f_raw.astype(jnp.float32))
    g = jnp.log(f)
    kk = 1.0 - f
    qq = jax.nn.silu(q_raw.astype(jnp.float32)) * (Dk ** -0.5)
    vv = i_in.astype(jnp.float32)

    def to_chunks(t):
        return t.reshape(B, n_chunks, CHUNK, H, t.shape[-1]).transpose(1, 0, 3, 2, 4)

    mask = jnp.tril(jnp.ones((CHUNK, CHUNK), dtype=bool))

    def step(state, xs):
        qc, kc, vc, gc = xs
        b = jnp.cumsum(gc, axis=2)
        o_inter = jnp.einsum('bhcd,bhde->bhce', qc * jnp.exp(b), state)
        rel = jnp.where(mask[None, None, :, :, None],
                        b[:, :, :, None, :] - b[:, :, None, :, :], -jnp.inf)
        attn = jnp.einsum('bhtd,bhsd,bhtsd->bhts', qc, kc, jnp.exp(rel))
        o_intra = jnp.einsum('bhts,bhse->bhte', attn, vc)
        b_last = b[:, :, -1:, :]
        new_state = (jnp.exp(b_last[:, :, 0, :])[..., None] * state
                     + jnp.einsum('bhsd,bhse->bhde', kc * jnp.exp(b_last - b), vc))
        return new_state, o_inter + o_intra

    s0 = jnp.zeros((B, H, Dk, Dv), jnp.float32)
    _, o = lax.scan(step, s0, (to_chunks(qq), to_chunks(kk), to_chunks(vv), to_chunks(g)))
    return o.transpose(1, 0, 3, 2, 4).reshape(B, S, H, Dv)


def moe_ffn(h, w_router, b_router, w_gu, b_gu, w_down, b_down):
    B, S, D = h.shape
    T = B * S
    xt = h.reshape(T, D)
    logits = (xt @ w_router).astype(jnp.float32) + b_router.astype(jnp.float32)
    top_val, top_idx = lax.top_k(logits, TOP_K)
    gates = jax.nn.softmax(top_val, axis=-1)
    A = T * TOP_K
    e_flat = top_idx.reshape(A)
    order = jnp.argsort(e_flat)
    e_sorted = e_flat[order]
    tok_sorted = (order // TOP_K).astype(jnp.int32)
    counts = jnp.bincount(e_flat, length=N_EXPERTS)
    starts = jnp.cumsum(counts) - counts
    padded = (counts + EXPERT_BLOCK - 1) // EXPERT_BLOCK * EXPERT_BLOCK
    pad_ends = jnp.cumsum(padded)
    pad_starts = pad_ends - padded
    dest = pad_starts[e_sorted] + (jnp.arange(A) - starts[e_sorted])
    n_blocks = -(-A // EXPERT_BLOCK) + N_EXPERTS
    P = n_blocks * EXPERT_BLOCK
    buf_tok = jnp.full((P,), T, dtype=jnp.int32).at[dest].set(tok_sorted)
    block_expert = jnp.minimum(
        jnp.searchsorted(pad_ends, jnp.arange(n_blocks) * EXPERT_BLOCK, side='right'),
        N_EXPERTS - 1)
    x_pad = jnp.concatenate([xt, jnp.zeros((1, D), xt.dtype)], axis=0)

    def expert_block(args):
        toks, e = args
        xb = x_pad[toks]
        gu = xb @ w_gu[e] + b_gu[e]
        gate, lin = gu[:, :D_FF], gu[:, D_FF:]
        gate = jnp.minimum(gate, SWIGLU_LIMIT)
        lin = jnp.clip(lin, -SWIGLU_LIMIT, SWIGLU_LIMIT)
        act = (lin + 1.0) * gate * jax.nn.sigmoid(SWIGLU_ALPHA * gate)
        return act @ w_down[e] + b_down[e]

    y_buf = lax.map(expert_block, (buf_tok.reshape(n_blocks, EXPERT_BLOCK), block_expert))
    y_buf = y_buf.reshape(P, D)
    y_assign = jnp.zeros((A, D), y_buf.dtype).at[order].set(y_buf[dest])
    y = jnp.einsum('tkd,tk->td', y_assign.reshape(T, TOP_K, D), gates.astype(y_buf.dtype))
    return y.reshape(B, S, D)


def setup_inputs(seed: int = 0) -> dict:
    key = jax.random.key(seed)
    ks = jax.random.split(key, 18)
    nrm = jax.random.normal
    f32 = jnp.float32
    return {
        "x": nrm(ks[0], (BATCH, SEQ, D_MODEL), f32),
        "w_in": nrm(ks[1], (DEPTH, D_MODEL, IN_WIDTH), f32) * D_MODEL ** -0.5,
        "w_up_a": nrm(ks[2], (DEPTH, A_WIDTH, D_MODEL), f32) * A_WIDTH ** -0.5,
        "w_up_b": nrm(ks[3], (DEPTH, B_WIDTH, D_MODEL), f32) * B_WIDTH ** -0.5,
        "w_out": nrm(ks[4], (DEPTH, D_MODEL, D_MODEL), f32) * D_MODEL ** -0.5,
        "norm_mix": 1.0 + 0.1 * nrm(ks[5], (DEPTH, D_MODEL), f32),
        "norm_ffn": 1.0 + 0.1 * nrm(ks[6], (DEPTH, D_MODEL), f32),
        "norm_final": 1.0 + 0.1 * nrm(ks[7], (D_MODEL,), f32),
        "hgrn_norm": 1.0 + 0.1 * nrm(ks[8], (DEPTH, B_HEADS, B_VAL_DIM), f32),
        "lb_logits": 0.5 * nrm(ks[9], (DEPTH + 1, B_HEADS * B_KEY_DIM), f32),
        "rel_bias": 0.5 * nrm(ks[10], (REL_BUCKETS, A_HEADS), f32),
        "w_router": nrm(ks[11], (DEPTH, D_MODEL, N_EXPERTS), f32) * D_MODEL ** -0.5,
        "b_router": 0.01 * nrm(ks[12], (DEPTH, N_EXPERTS), f32),
        "w_gu": nrm(ks[13], (DEPTH, N_EXPERTS, D_MODEL, 2 * D_FF), f32) * D_MODEL ** -0.5,
        "b_gu": 0.01 * nrm(ks[14], (DEPTH, N_EXPERTS, 2 * D_FF), f32),
        "w_down": nrm(ks[15], (DEPTH, N_EXPERTS, D_FF, D_MODEL), f32) * D_FF ** -0.5,
        "b_down": 0.01 * nrm(ks[16], (DEPTH, N_EXPERTS, D_MODEL), f32),
    }


def reference(x, w_in, w_up_a, w_up_b, w_out, norm_mix, norm_ffn, norm_final, hgrn_norm,
              lb_logits, rel_bias, w_router, b_router, w_gu, b_gu, w_down, b_down):
    B, S, _ = x.shape
    split_points = [int(p) for p in np.cumsum(IN_SPLITS)[:-1]]
    lb_all = jnp.cumsum(jax.nn.softmax(lb_logits.astype(jnp.float32), axis=0), axis=0)
    for l in range(DEPTH):
        h = rmsnorm(x, norm_mix[l])
        proj = h @ w_in[l]
        (aq, ak, av, iq, iw, ik, bq, bf, bi, bg, ga, gb) = jnp.split(proj, split_points, axis=-1)
        y_a = dsa_sparse_attention(
            aq.reshape(B, S, A_HEADS, A_HEAD_DIM),
            ak.reshape(B, S, A_HEADS, A_HEAD_DIM),
            av.reshape(B, S, A_HEADS, A_HEAD_DIM),
            iq.reshape(B, S, IDX_HEADS, IDX_DIM), iw, ik, rel_bias)
        lb = lb_all[l].reshape(B_HEADS, B_KEY_DIM)
        o_b = hgrn2_chunkwise(bq.reshape(B, S, B_HEADS, B_KEY_DIM),
                              bf.reshape(B, S, B_HEADS, B_KEY_DIM),
                              bi.reshape(B, S, B_HEADS, B_VAL_DIM), lb)
        o_b = rmsnorm(o_b, hgrn_norm[l]) * jax.nn.silu(
            bg.reshape(B, S, B_HEADS, B_VAL_DIM).astype(jnp.float32))
        y_b = o_b.reshape(B, S, B_WIDTH).astype(x.dtype)
        merged = (jax.nn.sigmoid(ga) * (y_a @ w_up_a[l])
                  + jax.nn.sigmoid(gb) * (y_b @ w_up_b[l]))
        x = x + merged @ w_out[l]
        x = x + moe_ffn(rmsnorm(x, norm_ffn[l]), w_router[l], b_router[l],
                        w_gu[l], b_gu[l], w_down[l], b_down[l])
    return rmsnorm(x, norm_final)
```

```cpp
#define MK_N_LAUNCHES 10
#include <hip/hip_runtime.h>
#include <cstdio>
#include <cstdint>

#ifndef MK_N_LAUNCHES
#define MK_N_LAUNCHES 1
#endif
#ifndef DBG_STAGE
#define DBG_STAGE -1
#endif

#define GAS __attribute__((address_space(1)))
#define LAS __attribute__((address_space(3)))
typedef unsigned short bf16;
typedef short bf16x8 __attribute__((ext_vector_type(8)));
typedef short s16x4 __attribute__((ext_vector_type(4)));
typedef float f32x2 __attribute__((ext_vector_type(2)));
typedef float f32x4 __attribute__((ext_vector_type(4)));
typedef float f32x16 __attribute__((ext_vector_type(16)));
typedef unsigned u32x2 __attribute__((ext_vector_type(2)));
typedef unsigned u32x4 __attribute__((ext_vector_type(4)));

constexpr int BATCH = 8, SEQ = 4096, DM = 1024, T = BATCH * SEQ;
constexpr int NPJ = 5632;
constexpr int C_AQ = 0, C_AK = 512, C_IQ = 1024, C_BQ = 1280, C_BF = 1792, C_BI = 2304, C_BG = 2816, C_GA = 3328, C_GB = 4352, C_IW = 5376, C_IK = 5384;
constexpr int NEXP = 32, DFF = 1024, TOPK = 4;
constexpr float EPS = 1e-6f;
constexpr int NPHASE = 10;

constexpr size_t MiB = 1u << 20;
constexpr size_t WS_CTL = 0, CTL_ZERO_BYTES = 1 * MiB;
constexpr size_t WS_WIN = 2 * MiB, WS_WV = 13 * MiB, WS_WUA = 14 * MiB, WS_WUB = 15 * MiB, WS_WO = 16 * MiB, WS_WGU = 18 * MiB, WS_WDN = 146 * MiB;
constexpr size_t WS_TOKL = 210 * MiB, WS_TOKI = 214 * MiB, WS_XN = 216 * MiB, WS_PROJ = 280 * MiB;
constexpr size_t WS_E = 632 * MiB;
constexpr size_t WS_VT = WS_E, WS_MASK = WS_E + 32 * MiB, WS_YA = WS_E + 48 * MiB, WS_YB = WS_E + 80 * MiB, WS_MRG = WS_E + 112 * MiB, WS_HU = WS_E + 176 * MiB, WS_HD = WS_E + 208 * MiB;
constexpr size_t WS_ACT = WS_PROJ, WS_YEXP = WS_E;
constexpr size_t WS_END = 904 * MiB;
constexpr int CW_TMO = 0, CW_CODE = 1, CW_CNT = 64  , CW_DBG = 1024, CW_BAR = 4096;

constexpr int RING_BYTES = 131072, MISC_OFF = RING_BYTES + 320, LDS_BYTES = 147456;

struct Args { const float* in[17]; float* out; unsigned char* ws; int ph_lo, ph_hi; };
__device__ __forceinline__ unsigned cvt_pk_bf16(float lo, float hi) { unsigned r; asm volatile("v_cvt_pk_bf16_f32 %0, %1, %2" : "=v"(r) : "v"(lo), "v"(hi)); return r; }
__device__ __forceinline__ float bf2f(unsigned short b) { return __uint_as_float((unsigned)b << 16); }
__device__ __forceinline__ float bflo(unsigned w) { return __uint_as_float(w << 16); }
__device__ __forceinline__ float bfhi(unsigned w) { return __uint_as_float(w & 0xffff0000u); }
__device__ __forceinline__ float sigmoidf_(float x) { return __builtin_amdgcn_rcpf(1.0f + __expf(-x)); }
__device__ __forceinline__ float wave_sum(float v) {
#pragma unroll
    for (int o = 1; o < 64; o <<= 1) v += __shfl_xor(v, o);
    return v;
}
#define LDS_WAIT() asm volatile("s_waitcnt lgkmcnt(0)" ::: "memory")
#define VM_WAIT() asm volatile("s_waitcnt vmcnt(0)" ::: "memory")

#define XB_TMO      128
#define XB_XCNT(j)  (256  + 64 * (j))
#define XB_XSUB(j)  (1280 + 64 * (j))
#define XB_XGEN(j)  (2304 + 64 * (j))
#define XB_TOP      3328
#define XB_TOPGEN   3392
#define XCD_BAR_WORDS 3456
#define XB_SPIN_CAP (1u << 18)
__device__ __forceinline__ unsigned xb_ld(unsigned* p)              { return __hip_atomic_load(p, __ATOMIC_RELAXED, __HIP_MEMORY_SCOPE_AGENT); }
__device__ __forceinline__ unsigned xb_add(unsigned* p, unsigned v) { return __hip_atomic_fetch_add(p, v, __ATOMIC_RELAXED, __HIP_MEMORY_SCOPE_AGENT); }
__device__ __forceinline__ unsigned xb_xcc_id() { return (unsigned)__builtin_amdgcn_s_getreg((3 << 11) | 20) & 0xFu; }
#define XB_SPIN(cond, bar) do { unsigned _sp = 0; while (cond) { __builtin_amdgcn_s_sleep(1); \
    if ((++_sp & 255u) == 0u) { if (xb_ld(&(bar)[XB_TMO])) break; if (_sp > XB_SPIN_CAP) { atomicAdd(&(bar)[XB_TMO], 1u); break; } } } } while (0)
struct XcdBarrier { unsigned* bar; unsigned x; volatile LAS unsigned* st; };
__device__ __forceinline__ XcdBarrier xcd_barrier_post(unsigned* bar, volatile LAS unsigned* st) {
    XcdBarrier b; b.bar = bar; b.x = xb_xcc_id(); b.st = st;
    if (threadIdx.x == 0) (void)xb_add(&bar[XB_XCNT(b.x)], 1u);
    return b;
}
__device__ __forceinline__ void xcd_barrier_complete(unsigned* bar, unsigned x, unsigned& nloc, unsigned& nx) {
    const unsigned G = gridDim.x * gridDim.y * gridDim.z;
    unsigned sum, cnt, mine, sp = 0u;
    for (;;) {
        sum = 0u; cnt = 0u; mine = 0u;
#pragma unroll
        for (unsigned j = 0; j < 16; ++j) { const unsigned c = xb_ld(&bar[XB_XCNT(j)]); sum += c; cnt += (c > 0u) ? 1u : 0u; mine = (j == x) ? c : mine; }
        if (sum == G) break;
        __builtin_amdgcn_s_sleep(1);
        if ((++sp & 255u) == 0u) { if (xb_ld(&bar[XB_TMO])) break; if (sp > XB_SPIN_CAP) { atomicAdd(&bar[XB_TMO], 1u); break; } }
    }
    nloc = mine > 0u ? mine : 1u; nx = cnt > 0u ? cnt : 1u;
}
__device__ __forceinline__ void xcd_barrier(const XcdBarrier& b) {
    asm volatile("s_waitcnt vmcnt(0)" ::: "memory");
    __syncthreads();
    if (threadIdx.x == 0) {
        unsigned* bar = b.bar;
        __builtin_amdgcn_s_waitcnt(0);
        unsigned nloc = b.st[0], nx = b.st[1];
        if (nloc == 0u) { xcd_barrier_complete(bar, b.x, nloc, nx); b.st[0] = nloc; b.st[1] = nx; }
        const unsigned old = xb_add(&bar[XB_XSUB(b.x)], 1u);
        const unsigned gen = old / nloc;
        if (old + 1u == (gen + 1u) * nloc) {
            __builtin_amdgcn_fence(__ATOMIC_RELEASE, "agent");
            asm volatile("s_waitcnt vmcnt(0)" ::: "memory");
            const unsigned og = xb_add(&bar[XB_TOP], 1u);
            const unsigned tg = og / nx;
            if (og + 1u == (tg + 1u) * nx) xb_add(&bar[XB_TOPGEN], 1u);
            else XB_SPIN(xb_ld(&bar[XB_TOPGEN]) == tg, bar);
            __builtin_amdgcn_fence(__ATOMIC_ACQUIRE, "agent");
            xb_add(&bar[XB_XGEN(b.x)], 1u);
            asm volatile("s_waitcnt vmcnt(0)" ::: "memory");
        } else {
            XB_SPIN(xb_ld(&bar[XB_XGEN(b.x)]) == gen, bar);
            __builtin_amdgcn_fence(__ATOMIC_ACQUIRE, "agent");
            asm volatile("s_waitcnt vmcnt(0)" ::: "memory");
        }
    }
    __syncthreads();
}
namespace pg8 {
constexpr int BM = 256, BK = 64, HALF = 128, HTB = HALF * BK * 2, STAGE_BYTES = 8 * HTB, NXCD = 8, WGM = 8;
__host__ __device__ __forceinline__ int lds_byte(int r, int c) { const int st = (r >> 4) * 2 + (c >> 5), rr = r & 15, cc = c & 31, ob = rr * 64 + cc * 2; return st * 1024 + (ob ^ (((ob >> 9) & 1) << 5)); }
__host__ __device__ __forceinline__ void stage_rc(int b, int& R, int& C) { const int st = b / 1024, sb = b % 1024, swz = sb ^ (((sb >> 9) & 1) << 5); R = (st >> 1) * 16 + swz / 64; C = (st & 1) * 32 + (swz % 64) / 2; }
__host__ __device__ __forceinline__ int perm32(int rho) { const int n = rho >> 4, i = rho & 15; return 8 * (i >> 2) + 4 * n + (i & 3); }

struct Unit { const char* A0; const char* B0; int orow, pn, e, rt; };

struct StaticSched {
    const bf16* A; const bf16* Bt; int K, nM, nN, nwg, G, c;
    __device__ __forceinline__ void init(const bf16* A_, const bf16* Bt_, int M, int N, int K_, int G_, int c_) { A = A_; Bt = Bt_; K = K_; nM = M / BM; nN = N / BM; nwg = nM * nN; G = G_; c = c_; }
    __device__ __forceinline__ bool next(int i, Unit& u) const {
        const long L = (long)i * G + c; if (L >= nwg) return false;
        int wgid = (int)L; { const int q = nwg / NXCD, r = nwg % NXCD, xcd = wgid % NXCD, off = wgid / NXCD; wgid = (xcd < r ? xcd * (q + 1) : r * (q + 1) + (xcd - r) * q) + off; }
        const int nig = WGM * nN, gid = wgid / nig, fm = gid * WGM, gsz = (nM - fm) < WGM ? (nM - fm) : WGM;
        const int pm = fm + ((wgid % nig) % gsz), pn = (wgid % nig) / gsz;
        u.A0 = (const char*)A + (size_t)pm * BM * K * 2; u.B0 = (const char*)Bt + (size_t)pn * BM * K * 2; u.orow = pm * BM; u.pn = pn; u.e = 0; u.rt = 0; return true;
    }
    __device__ __forceinline__ void offs(const Unit&, const int (&R)[2], const int (&C)[2], unsigned (&o)[2][2]) const {
#pragma unroll
        for (int h = 0; h < 2; ++h)
#pragma unroll
            for (int i = 0; i < 2; ++i) o[h][i] = (unsigned)((h * HALF + R[i]) * K + C[i]) * 2u;
    }
};

template <bool GATHER> struct MoeSched {
    const bf16* XA; const bf16* W; const int* toklist; const int* cnt  ; const LAS int* tstart; int K, npn, nrows_w  , G, c;
    __device__ __forceinline__ bool next(int i, Unit& u) const {
        const long L = (long)i * G + c; const int ntile = tstart[NEXP];
        if (L >= (long)ntile * npn) return false;
        const int rtg = (int)(L / npn), pn = (int)(L % npn);
        int e = 0;
#pragma unroll 1
        for (int k = 1; k < NEXP; ++k) e += (tstart[k] <= rtg) ? 1 : 0;
        e = __builtin_amdgcn_readfirstlane(e);
        u.e = e; u.rt = rtg - tstart[e]; u.pn = pn; u.orow = rtg * BM;
        u.A0 = GATHER ? (const char*)XA : (const char*)XA + (size_t)rtg * BM * K * 2;
        u.B0 = (const char*)W + ((size_t)e * nrows_w + (size_t)pn * BM) * K * 2;
        return true;
    }
    __device__ __forceinline__ void offs(const Unit& u, const int (&R)[2], const int (&C)[2], unsigned (&o)[2][2]) const {
        if (GATHER) {
            const int n = cnt[16 * u.e];
#pragma unroll
            for (int h = 0; h < 2; ++h)
#pragma unroll
                for (int i = 0; i < 2; ++i) { const int r = u.rt * BM + h * HALF + R[i]; const int tok = (r < n) ? toklist[u.e * T + r] : 0; o[h][i] = (unsigned)(tok * K + C[i]) * 2u; }
        } else {
#pragma unroll
            for (int h = 0; h < 2; ++h)
#pragma unroll
                for (int i = 0; i < 2; ++i) o[h][i] = (unsigned)((h * HALF + R[i]) * K + C[i]) * 2u;
        }
    }
};

template <class Epi, class Sched>
__device__ __forceinline__ void gemm_phase(LAS unsigned char* lds, const int K, const Sched& S, const Epi& E) {
    const int tid = threadIdx.x, wid = __builtin_amdgcn_readfirstlane(tid >> 6), lane = tid & 63, wr = wid >> 2, wc = wid & 3, fr = lane & 15, fq = lane >> 4;
    const int nt = K / BK;
    int Rr[2], Cc[2]; unsigned voffB[2];
#pragma unroll
    for (int i = 0; i < 2; ++i) { int R, C; stage_rc(tid * 16 + i * 8192, R, C); Rr[i] = R; Cc[i] = C; const int Rb = Epi::PERM ? ((R & ~31) + perm32(R & 31)) : R; voffB[i] = (unsigned)(Rb * K + C) * 2u; }
    const size_t kstep = (size_t)(BK * 2);
    const size_t hstep = (size_t)HALF * K * 2;
    const unsigned ldsw = (unsigned)wid * 1024u;
    const int aoff = lds_byte(wr * 64 + fr, fq * 8), boff = lds_byte(wc * 32 + fr, fq * 8);
#define PG8_SA(b, h) (((b) * 2 + (h)) * HTB)
#define PG8_SB(b, h) ((4 + (b) * 2 + (h)) * HTB)
#define PG8_STAGE(bufoff, gbase, voff) do { _Pragma("unroll") for (int _i = 0; _i < 2; ++_i) \
        __builtin_amdgcn_global_load_lds((const unsigned*)((const char*)(gbase) + (voff)[_i]), (LAS unsigned*)(lds + (bufoff) + ldsw + _i * 8192), 16, 0, 0); } while (0)
#define PG8_LDA(dst, b, h) do { _Pragma("unroll") for (int m = 0; m < 4; ++m) _Pragma("unroll") for (int k = 0; k < 2; ++k) dst[m][k] = *(const LAS bf16x8*)(lds + PG8_SA(b, h) + aoff + m * 2048 + k * 1024); } while (0)
#define PG8_LDB(dst, b, h) do { _Pragma("unroll") for (int n = 0; n < 2; ++n) _Pragma("unroll") for (int k = 0; k < 2; ++k) dst[n][k] = *(const LAS bf16x8*)(lds + PG8_SB(b, h) + boff + n * 2048 + k * 1024); } while (0)
#define PG8_MMA(ai, bj, At, Bt) do { __builtin_amdgcn_s_setprio(1); _Pragma("unroll") for (int m = 0; m < 4; ++m) _Pragma("unroll") for (int n = 0; n < 2; ++n) _Pragma("unroll") for (int k = 0; k < 2; ++k) \
        acc[ai][bj][m][n] = __builtin_amdgcn_mfma_f32_16x16x32_bf16(Bt[n][k], At[m][k], acc[ai][bj][m][n], 0, 0, 0); __builtin_amdgcn_s_setprio(0); } while (0)
#define PG8_WAIT_V(n) asm volatile("s_waitcnt vmcnt(" #n ")" ::: "memory")
#define PG8_WAIT_L(n) asm volatile("s_waitcnt lgkmcnt(" #n ")" ::: "memory")
#define PG8_BAR __builtin_amdgcn_s_barrier()
#define PG8_SCHED __builtin_amdgcn_sched_barrier(0)
    Unit cur, nxt; int ui = 0;
    if (!S.next(0, cur)) return;
    f32x4 acc[2][2][4][2];
#pragma unroll
    for (int a = 0; a < 2; ++a)
#pragma unroll
        for (int b = 0; b < 2; ++b)
#pragma unroll
            for (int m = 0; m < 4; ++m)
#pragma unroll
                for (int n = 0; n < 2; ++n) acc[a][b][m][n] = (f32x4){0.f, 0.f, 0.f, 0.f};
    bf16x8 At[4][2], B0[2][2], B1[2][2];
    unsigned cO[2][2], nO[2][2];
    S.offs(cur, Rr, Cc, cO);
    const char* cA = cur.A0; const char* cB = cur.B0;
    PG8_STAGE(PG8_SB(0, 0), cB, voffB); PG8_STAGE(PG8_SB(0, 1), cB + hstep, voffB); PG8_STAGE(PG8_SA(0, 0), cA, cO[0]); PG8_STAGE(PG8_SA(0, 1), cA, cO[1]);
    if (wr == 1) PG8_BAR;
    PG8_WAIT_V(2); PG8_BAR;
    PG8_STAGE(PG8_SB(1, 0), cB + kstep, voffB); PG8_STAGE(PG8_SA(1, 0), cA + kstep, cO[0]); PG8_STAGE(PG8_SB(1, 1), cB + hstep + kstep, voffB);
    PG8_WAIT_V(6); PG8_BAR;
    for (;;) {
        const bool has_next = S.next(ui + 1, nxt);
        const char* nA = has_next ? nxt.A0 : cA; const char* nB = has_next ? nxt.B0 : cB;
        if (has_next) { S.offs(nxt, Rr, Cc, nO);
#pragma unroll
            for (int h = 0; h < 2; ++h)
#pragma unroll
                for (int i = 0; i < 2; ++i) asm volatile("" : "+v"(nO[h][i]));
        } else {
#pragma unroll
            for (int h = 0; h < 2; ++h)
#pragma unroll
                for (int i = 0; i < 2; ++i) nO[h][i] = cO[h][i]; }
        for (int t = 0; t < nt; t += 2) {
            const bool last = (t == nt - 2);
            const char* a1 = cA + (size_t)(t + 1) * kstep;
            const char* a2 = last ? nA : cA + (size_t)(t + 2) * kstep; const char* b2 = last ? nB : cB + (size_t)(t + 2) * kstep;
            const char* a3 = a2 + kstep; const char* b3 = b2 + kstep;
            unsigned o2[2][2];
#pragma unroll
            for (int h = 0; h < 2; ++h)
#pragma unroll
                for (int i = 0; i < 2; ++i) o2[h][i] = last ? nO[h][i] : cO[h][i];
            PG8_LDB(B0, 0, 0); PG8_LDB(B1, 0, 1); PG8_SCHED; PG8_LDA(At, 0, 0); PG8_STAGE(PG8_SA(1, 1), a1, cO[1]);
            PG8_WAIT_V(8); PG8_WAIT_L(0); PG8_BAR; PG8_MMA(0, 0, At, B0); PG8_MMA(0, 1, At, B1); PG8_BAR; PG8_SCHED;
            PG8_LDA(At, 0, 1); PG8_STAGE(PG8_SB(0, 0), b2, voffB); PG8_STAGE(PG8_SB(0, 1), b2 + hstep, voffB); PG8_STAGE(PG8_SA(0, 0), a2, o2[0]);
            PG8_WAIT_V(8); PG8_WAIT_L(0); PG8_BAR; PG8_MMA(1, 0, At, B0); PG8_MMA(1, 1, At, B1); PG8_BAR; PG8_SCHED;
            PG8_LDB(B0, 1, 0); PG8_LDB(B1, 1, 1); PG8_SCHED; PG8_LDA(At, 1, 0); PG8_STAGE(PG8_SA(0, 1), a2, o2[1]);
            PG8_WAIT_V(8); PG8_WAIT_L(0); PG8_BAR; PG8_MMA(0, 0, At, B0); PG8_MMA(0, 1, At, B1); PG8_BAR; PG8_SCHED;
            PG8_LDA(At, 1, 1); PG8_STAGE(PG8_SB(1, 0), b3, voffB); PG8_STAGE(PG8_SB(1, 1), b3 + hstep, voffB); PG8_STAGE(PG8_SA(1, 0), a3, o2[0]);
            PG8_WAIT_V(8); PG8_WAIT_L(0); PG8_BAR; PG8_MMA(1, 0, At, B0); PG8_MMA(1, 1, At, B1); PG8_BAR; PG8_SCHED;
        }
        if (wr == 0) PG8_BAR;
        E(acc, cur, wr, wc, fr, fq);
        if (!has_next) break;
#pragma unroll
        for (int a = 0; a < 2; ++a)
#pragma unroll
            for (int b = 0; b < 2; ++b)
#pragma unroll
                for (int m = 0; m < 4; ++m)
#pragma unroll
                    for (int n = 0; n < 2; ++n) acc[a][b][m][n] = (f32x4){0.f, 0.f, 0.f, 0.f};
        cur = nxt; cA = nA; cB = nB; ++ui;
#pragma unroll
        for (int h = 0; h < 2; ++h)
#pragma unroll
            for (int i = 0; i < 2; ++i) cO[h][i] = nO[h][i];
        if (wr == 1) PG8_BAR;
    }
    PG8_WAIT_V(0);
    PG8_BAR;
#undef PG8_SA
#undef PG8_SB
#undef PG8_STAGE
#undef PG8_LDA
#undef PG8_LDB
#undef PG8_MMA
#undef PG8_WAIT_V
#undef PG8_WAIT_L
#undef PG8_BAR
#undef PG8_SCHED
}

struct EpiBf16 {
    static constexpr bool PERM = true;
    bf16* O; int ldc; const float* bias; int bias_ld;
    __device__ __forceinline__ void operator()(const f32x4 (&acc)[2][2][4][2], const Unit& u, int wr, int wc, int fr, int fq) const {
        const int row0 = u.orow + wr * 64 + fr, col0 = u.pn * BM + wc * 32 + 8 * fq;
        f32x4 bv[2][2];
#pragma unroll
        for (int bj = 0; bj < 2; ++bj)
#pragma unroll
            for (int n = 0; n < 2; ++n) bv[bj][n] = bias ? *(const f32x4*)(bias + (size_t)u.e * bias_ld + col0 + bj * HALF + 4 * n) : (f32x4){0.f, 0.f, 0.f, 0.f};
#pragma unroll
        for (int ai = 0; ai < 2; ++ai)
#pragma unroll
            for (int m = 0; m < 4; ++m) { bf16* rowp = O + (size_t)(row0 + ai * HALF + m * 16) * ldc + col0;
#pragma unroll
                for (int bj = 0; bj < 2; ++bj) { const f32x4 v0 = acc[ai][bj][m][0] + bv[bj][0], v1 = acc[ai][bj][m][1] + bv[bj][1];
                    u32x4 w; w.x = cvt_pk_bf16(v0[0], v0[1]); w.y = cvt_pk_bf16(v0[2], v0[3]); w.z = cvt_pk_bf16(v1[0], v1[1]); w.w = cvt_pk_bf16(v1[2], v1[3]);
                    *(u32x4*)(rowp + bj * HALF) = w; } }
    }
};
template <bool FIRST> struct EpiMerge {
    static constexpr bool PERM = true;
    const bf16* Gt; bf16* O;
    __device__ __forceinline__ void operator()(const f32x4 (&acc)[2][2][4][2], const Unit& u, int wr, int wc, int fr, int fq) const {
        const int row0 = u.orow + wr * 64 + fr, col0 = u.pn * BM + wc * 32 + 8 * fq;
#pragma unroll
        for (int ai = 0; ai < 2; ++ai)
#pragma unroll
            for (int m = 0; m < 4; ++m) { const size_t r = (size_t)(row0 + ai * HALF + m * 16);
#pragma unroll
                for (int bj = 0; bj < 2; ++bj) { const u32x4 gw = *(const u32x4*)(Gt + r * NPJ + col0 + bj * HALF);
                    f32x4 v0 = acc[ai][bj][m][0], v1 = acc[ai][bj][m][1];
                    v0[0] *= sigmoidf_(bflo(gw.x)); v0[1] *= sigmoidf_(bfhi(gw.x)); v0[2] *= sigmoidf_(bflo(gw.y)); v0[3] *= sigmoidf_(bfhi(gw.y));
                    v1[0] *= sigmoidf_(bflo(gw.z)); v1[1] *= sigmoidf_(bfhi(gw.z)); v1[2] *= sigmoidf_(bflo(gw.w)); v1[3] *= sigmoidf_(bfhi(gw.w));
                    bf16* op = O + r * DM + col0 + bj * HALF;
                    if (!FIRST) { const u32x4 pw = *(const u32x4*)op;
                        v0[0] += bflo(pw.x); v0[1] += bfhi(pw.x); v0[2] += bflo(pw.y); v0[3] += bfhi(pw.y); v1[0] += bflo(pw.z); v1[1] += bfhi(pw.z); v1[2] += bflo(pw.w); v1[3] += bfhi(pw.w); }
                    u32x4 w; w.x = cvt_pk_bf16(v0[0], v0[1]); w.y = cvt_pk_bf16(v0[2], v0[3]); w.z = cvt_pk_bf16(v1[0], v1[1]); w.w = cvt_pk_bf16(v1[2], v1[3]);
                    *(u32x4*)op = w; } }
    }
};
struct EpiOutRes {
    static constexpr bool PERM = false;
    const float* X; float* O;
    __device__ __forceinline__ void operator()(const f32x4 (&acc)[2][2][4][2], const Unit& u, int wr, int wc, int fr, int fq) const {
        const int row0 = u.orow + wr * 64 + fr, col0 = u.pn * BM + wc * 32 + 4 * fq;
#pragma unroll
        for (int ai = 0; ai < 2; ++ai)
#pragma unroll
            for (int m = 0; m < 4; ++m) { const size_t off = (size_t)(row0 + ai * HALF + m * 16) * DM + col0;
#pragma unroll
                for (int bj = 0; bj < 2; ++bj)
#pragma unroll
                    for (int n = 0; n < 2; ++n) { const f32x4 xv = *(const f32x4*)(X + off + bj * HALF + n * 16); *(f32x4*)(O + off + bj * HALF + n * 16) = xv + acc[ai][bj][m][n]; } }
    }
};
struct EpiSwiGLU {
    static constexpr bool PERM = true;
    const float* bgu; bf16* O;
    __device__ __forceinline__ void operator()(const f32x4 (&acc)[2][2][4][2], const Unit& u, int wr, int wc, int fr, int fq) const {
        const int row0 = u.orow + wr * 64 + fr, col0 = u.pn * HALF + wc * 32 + 8 * fq;
        const float* bg = bgu + (size_t)u.e * 2 * DFF + col0;
        f32x4 bgt[2], bln[2];
#pragma unroll
        for (int n = 0; n < 2; ++n) { bgt[n] = *(const f32x4*)(bg + 4 * n); bln[n] = *(const f32x4*)(bg + DFF + 4 * n); }
#pragma unroll
        for (int ai = 0; ai < 2; ++ai)
#pragma unroll
            for (int m = 0; m < 4; ++m) { float o[8];
#pragma unroll
                for (int n = 0; n < 2; ++n) { const f32x4 gt = acc[ai][0][m][n] + bgt[n], ln = acc[ai][1][m][n] + bln[n];
#pragma unroll
                    for (int j = 0; j < 4; ++j) { const float gg = fminf(gt[j], 7.0f), ll = fminf(fmaxf(ln[j], -7.0f), 7.0f); o[4 * n + j] = (ll + 1.0f) * gg * sigmoidf_(1.702f * gg); } }
                u32x4 w; w.x = cvt_pk_bf16(o[0], o[1]); w.y = cvt_pk_bf16(o[2], o[3]); w.z = cvt_pk_bf16(o[4], o[5]); w.w = cvt_pk_bf16(o[6], o[7]);
                *(u32x4*)(O + (size_t)(row0 + ai * HALF + m * 16) * DFF + col0) = w; }
    }
};
}
__device__ __forceinline__ int srccol_in(int n) {
    if (n < 1024) return n;
    if (n < 1280) return 1536 + (n - 1024);
    if (n < 1792) return 1832 + (n - 1280);
    if (n < 2304) return 2344 + (n - 1792);
    if (n < 2816) return 2856 + (n - 2304);
    if (n < 3328) return 3368 + (n - 2816);
    if (n < 4352) return 3880 + (n - 3328);
    if (n < 5376) return 4904 + (n - 4352);
    if (n < 5384) return 1792 + (n - 5376);
    if (n < 5416) return 1800 + (n - 5384);
    return -1;
}
template <int MAP> __device__ __forceinline__ int srccol(int n) {
    if (MAP == 1) return srccol_in(n);
    if (MAP == 2) return 1024 + n;
    if (MAP == 3) { const int pn = n >> 8, j = n & 255; return j < 128 ? pn * 128 + j : 1024 + pn * 128 + (j - 128); }
    return n;
}
template <int MAP> __device__ __forceinline__ void tr_item(const float* W, int ldw, int Kd, bf16* WT, int k0, int n0, LAS float* scr, int lane) {
    const int nq = lane & 7, sc = srccol<MAP>(n0 + 4 * nq);
#pragma unroll
    for (int i = 0; i < 8; ++i) { const int kk = (lane >> 3) + 8 * i;
        f32x4 v = (f32x4){0.f, 0.f, 0.f, 0.f}; if (sc >= 0) v = *(const f32x4*)(W + (size_t)(k0 + kk) * ldw + sc);
        LAS float* d = scr + kk * 33 + 4 * nq; d[0] = v[0]; d[1] = v[1]; d[2] = v[2]; d[3] = v[3]; }
    LDS_WAIT(); asm volatile("" ::: "memory");
    const int c = lane & 7;
#pragma unroll
    for (int j = 0; j < 4; ++j) { const int n = (lane >> 3) + 8 * j; const LAS float* s = scr + (8 * c) * 33 + n;
        u32x4 o; o.x = cvt_pk_bf16(s[0 * 33], s[1 * 33]); o.y = cvt_pk_bf16(s[2 * 33], s[3 * 33]); o.z = cvt_pk_bf16(s[4 * 33], s[5 * 33]); o.w = cvt_pk_bf16(s[6 * 33], s[7 * 33]);
        *(u32x4*)(WT + (size_t)(n0 + n) * Kd + k0 + 8 * c) = o; }
    LDS_WAIT(); asm volatile("" ::: "memory");
}
template <int MAP> __device__ __forceinline__ void tr_matrix(const float* W, int ldw, int Kd, int Nd, bf16* WT, LAS float* scr, int lane, int gw, int NGW) {
    const int nkb = Kd / 64, nnb = Nd / 32, n = nkb * nnb;
    for (int it = gw; it < n; it += NGW) { const int kb = it / nnb, nb = it % nnb; tr_item<MAP>(W, ldw, Kd, WT, 64 * kb, 32 * nb, scr, lane); }
}
__device__ __forceinline__ void rms_row_to_bf16(const float* xrow, const float* gain, bf16* orow, int lane) {
    const f32x4* xr = (const f32x4*)xrow + lane; const f32x4* gr = (const f32x4*)gain + lane;
    f32x4 v[4]; float s = 0.f;
#pragma unroll
    for (int j = 0; j < 4; ++j) { v[j] = xr[64 * j]; s += (v[j][0] * v[j][0] + v[j][1] * v[j][1]) + (v[j][2] * v[j][2] + v[j][3] * v[j][3]); }
    const float rstd = rsqrtf(wave_sum(s) * (1.f / DM) + EPS);
    u32x2* o8 = (u32x2*)orow + lane;
#pragma unroll
    for (int j = 0; j < 4; ++j) { const f32x4 g = gr[64 * j]; u32x2 w; w.x = cvt_pk_bf16(v[j][0] * rstd * g[0], v[j][1] * rstd * g[1]); w.y = cvt_pk_bf16(v[j][2] * rstd * g[2], v[j][3] * rstd * g[3]); o8[64 * j] = w; }
}

struct P0Args { const float *x, *w_in, *w_up_a, *w_up_b, *w_out, *norm_mix, *w_gu, *w_down; unsigned char* ws; };
__device__ __forceinline__ void p0_prologue(const P0Args& a, LAS unsigned char* lds, int wave, int lane, int vcu, int G) {
    LAS float* scr = (LAS float*)(lds + wave * 16384);
    const int gw = vcu * 8 + wave, NGW = G * 8;
    unsigned char* ws = a.ws;
    tr_matrix<1>(a.w_in, 5928, DM, NPJ, (bf16*)(ws + WS_WIN), scr, lane, gw, NGW);
    tr_matrix<2>(a.w_in, 5928, DM, 512, (bf16*)(ws + WS_WV), scr, lane, gw, NGW);
    tr_matrix<0>(a.w_up_a, DM, 512, DM, (bf16*)(ws + WS_WUA), scr, lane, gw, NGW);
    tr_matrix<0>(a.w_up_b, DM, 512, DM, (bf16*)(ws + WS_WUB), scr, lane, gw, NGW);
    tr_matrix<0>(a.w_out, DM, DM, DM, (bf16*)(ws + WS_WO), scr, lane, gw, NGW);
    for (int m = gw; m < T; m += NGW) rms_row_to_bf16(a.x + (size_t)m * DM, a.norm_mix, (bf16*)(ws + WS_XN) + (size_t)m * DM, lane);
    for (int e = 0; e < NEXP; ++e) {
        tr_matrix<3>(a.w_gu + (size_t)e * DM * 2 * DFF, 2 * DFF, DM, 2 * DFF, (bf16*)(ws + WS_WGU) + (size_t)e * 2 * DFF * DM, scr, lane, (gw + 61 * e) % NGW, NGW);
        tr_matrix<0>(a.w_down + (size_t)e * DFF * DM, DM, DFF, DM, (bf16*)(ws + WS_WDN) + (size_t)e * DM * DFF, scr, lane, (gw + 37 * e) % NGW, NGW);
    }
}

struct P6Args { const float* x1; const float* norm_ffn; const float* w_router; const float* b_router; bf16* h2; unsigned* cnt; int* tokl; u32x2* toki; };
__device__ __forceinline__ void p6_router(const P6Args& a, LAS unsigned char* lds, int tid, int wave, int lane, int vcu, int G) {
    LAS float* xs = (LAS float*)lds;
    LAS float* part = (LAS float*)(lds + 65536);
    LAS unsigned* lcnt = (LAS unsigned*)(lds + 98304);
    LAS unsigned* lbase = lcnt + 32;
    LAS unsigned* lsel = lcnt + 64;
    LAS float* lgate = (LAS float*)(lcnt + 64 + 512);
    const int rows_per = 128;
    for (int base = vcu * rows_per; base < T; base += G * rows_per) {
        if (tid < 32) lcnt[tid] = 0u;
        __syncthreads();
        for (int ch = 0; ch < 8; ++ch) {
#pragma unroll 1
            for (int q = 0; q < 2; ++q) { const int r = 2 * wave + q, t = base + ch * 16 + r;
                const f32x4* xr = (const f32x4*)(a.x1 + (size_t)t * DM) + lane; const f32x4* gr = (const f32x4*)a.norm_ffn + lane;
                f32x4 v[4]; float s = 0.f;
#pragma unroll
                for (int j = 0; j < 4; ++j) { v[j] = xr[64 * j]; s += (v[j][0] * v[j][0] + v[j][1] * v[j][1]) + (v[j][2] * v[j][2] + v[j][3] * v[j][3]); }
                const float rstd = rsqrtf(wave_sum(s) * (1.f / DM) + EPS);
                u32x2* o8 = (u32x2*)(a.h2 + (size_t)t * DM) + lane;
#pragma unroll
                for (int j = 0; j < 4; ++j) { const f32x4 g = gr[64 * j]; v[j] = v[j] * rstd * g; u32x2 w; w.x = cvt_pk_bf16(v[j][0], v[j][1]); w.y = cvt_pk_bf16(v[j][2], v[j][3]); o8[64 * j] = w;
                    *(LAS f32x4*)(xs + r * 1024 + 4 * lane + 256 * j) = v[j]; }
            }
            __syncthreads();
            { const int e = lane & 31, kh = lane >> 5, k0 = 128 * wave + 64 * kh;
              float acc[16];
#pragma unroll
              for (int r = 0; r < 16; ++r) acc[r] = 0.f;
#pragma unroll 2
              for (int kk = 0; kk < 64; kk += 4) { const float* wp = a.w_router + (size_t)(k0 + kk) * NEXP + e;
                  const float w0 = wp[0], w1 = wp[NEXP], w2 = wp[2 * NEXP], w3 = wp[3 * NEXP];
#pragma unroll
                  for (int r = 0; r < 16; ++r) { const f32x4 xv = *(const LAS f32x4*)(xs + r * 1024 + k0 + kk); acc[r] += (xv[0] * w0 + xv[1] * w1) + (xv[2] * w2 + xv[3] * w3); } }
#pragma unroll
              for (int r = 0; r < 16; ++r) part[((wave * 2 + kh) * 16 + r) * 32 + e] = acc[r];
            }
            __syncthreads();
            { const int r = tid >> 5, e = tid & 31; float lg = a.b_router[e];
#pragma unroll
              for (int p = 0; p < 16; ++p) lg += part[(p * 16 + r) * 32 + e];
              float tv[4]; int te[4]; float cur = lg;
#pragma unroll
              for (int k = 0; k < 4; ++k) { float bv = cur; int be = e;
#pragma unroll
                  for (int o = 1; o < 32; o <<= 1) { const float ov = __shfl_xor(bv, o); const int oe = __shfl_xor(be, o); if (ov > bv || (ov == bv && oe < be)) { bv = ov; be = oe; } }
                  tv[k] = bv; te[k] = be; if (e == be) cur = -INFINITY; }
              const float e1 = __expf(tv[1] - tv[0]), e2 = __expf(tv[2] - tv[0]), e3 = __expf(tv[3] - tv[0]); const float inv = 1.f / (1.f + e1 + e2 + e3);
              if (e < 4) { const int ee = e == 0 ? te[0] : e == 1 ? te[1] : e == 2 ? te[2] : te[3]; const float gg = (e == 0 ? 1.f : e == 1 ? e1 : e == 2 ? e2 : e3) * inv;
                  const unsigned lr = __hip_atomic_fetch_add(&lcnt[ee], 1u, __ATOMIC_RELAXED, __HIP_MEMORY_SCOPE_WORKGROUP); const int ri = ch * 16 + r; lsel[ri * 4 + e] = (unsigned)ee | (lr << 8); lgate[ri * 4 + e] = gg; }
            }
            __syncthreads();
        }
        if (tid < 32) lbase[tid] = __hip_atomic_fetch_add(a.cnt + 16 * tid, lcnt[tid], __ATOMIC_RELAXED, __HIP_MEMORY_SCOPE_AGENT);
        __syncthreads();
        for (int i = tid; i < rows_per * 4; i += 512) { const unsigned s = lsel[i]; const int e = s & 255; const unsigned pos = lbase[e] + (s >> 8); const int t = base + (i >> 2);
            a.toki[(size_t)t * 4 + (i & 3)] = (u32x2){(unsigned)e | (pos << 8), __float_as_uint(lgate[i])}; a.tokl[(size_t)e * T + pos] = t; }
        __syncthreads();
    }
}

__device__ __forceinline__ void p9_final(float* out, const bf16* yexp, const u32x2* toki, const unsigned* cnt, const float* norm_final, LAS unsigned char* lds, int tid, int wave, int lane, int vcu, int G) {
    LAS int* pst = (LAS int*)lds;
    if (tid == 0) { int acc = 0; for (int e = 0; e < NEXP; ++e) { pst[e] = acc; acc += ((int)cnt[16 * e] + 255) / 256 * 256; } }
    __syncthreads();
    const int gw = vcu * 8 + wave, NGW = G * 8;
    for (int t = gw; t < T; t += NGW) {
        f32x4* xr = (f32x4*)(out + (size_t)t * DM) + lane; const f32x4* gr = (const f32x4*)norm_final + lane;
        f32x4 v[4];
#pragma unroll
        for (int j = 0; j < 4; ++j) v[j] = xr[64 * j];
#pragma unroll
        for (int k = 0; k < 4; ++k) { const u32x2 ti = toki[(size_t)t * 4 + k]; const int e = ti.x & 255; const int pos = ti.x >> 8; const float g = __uint_as_float(ti.y);
            const u32x2* yr = (const u32x2*)(yexp + (size_t)(pst[e] + pos) * DM) + lane;
#pragma unroll
            for (int j = 0; j < 4; ++j) { const u32x2 w = yr[64 * j]; v[j][0] += g * bflo(w.x); v[j][1] += g * bfhi(w.x); v[j][2] += g * bflo(w.y); v[j][3] += g * bfhi(w.y); } }
        float s = 0.f;
#pragma unroll
        for (int j = 0; j < 4; ++j) s += (v[j][0] * v[j][0] + v[j][1] * v[j][1]) + (v[j][2] * v[j][2] + v[j][3] * v[j][3]);
        const float rstd = rsqrtf(wave_sum(s) * (1.f / DM) + EPS);
#pragma unroll
        for (int j = 0; j < 4; ++j) { const f32x4 g = gr[64 * j]; xr[64 * j] = v[j] * rstd * g; }
    }
}
#define HAVE_MIX 1
struct MixArgs { const bf16* PROJ; const bf16* VT; unsigned short* MASKQ; bf16* YA; bf16* YB; float* HU; float* HD; const float* hgrn_norm; const float* lb_logits; const float* rel_bias; };
__device__ const unsigned char T5BUCKET[129] = {0, 1, 2, 3, 4, 5, 6, 7, 8, 9, 10, 11, 12, 13, 14, 15, 16, 16, 16, 17, 17, 18, 18, 18, 19, 19, 19, 20, 20, 20, 20, 21, 21, 21, 21, 22, 22, 22, 22, 22, 23, 23, 23, 23, 23, 23, 24, 24, 24, 24, 24, 24, 25, 25, 25, 25, 25, 25, 25, 26, 26, 26, 26, 26, 26, 26, 26, 27, 27, 27, 27, 27, 27, 27, 27, 27, 27, 28, 28, 28, 28, 28, 28, 28, 28, 28, 28, 29, 29, 29, 29, 29, 29, 29, 29, 29, 29, 29, 29, 30, 30, 30, 30, 30, 30, 30, 30, 30, 30, 30, 30, 30, 30, 31, 31, 31, 31, 31, 31, 31, 31, 31, 31, 31, 31, 31, 31, 31, 31};
constexpr float LOG2E = 1.4426950408889634f;
__device__ __forceinline__ bf16x8 pack8(float a0, float a1, float a2, float a3, float a4, float a5, float a6, float a7) {
    u32x4 w; w.x = cvt_pk_bf16(a0, a1); w.y = cvt_pk_bf16(a2, a3); w.z = cvt_pk_bf16(a4, a5); w.w = cvt_pk_bf16(a6, a7); return __builtin_bit_cast(bf16x8, w);
}
__device__ __forceinline__ bf16x8 lo4(u32x2 v) { u32x4 w; w.x = v.x; w.y = v.y; w.z = 0u; w.w = 0u; return __builtin_bit_cast(bf16x8, w); }

__device__ __forceinline__ void pidx_unit(const MixArgs& m, LAS unsigned char* lds, int tid, int wave, int lane, int b, int qt) {
    LAS unsigned* hist = (LAS unsigned*)lds;
    LAS unsigned* s_pfx = (LAS unsigned*)(lds + 16512);
    LAS unsigned* s_k2 = (LAS unsigned*)(lds + 16640);
    LAS unsigned* s_krem = (LAS unsigned*)(lds + 16768);
    LAS unsigned* kbq = (LAS unsigned*)(lds + 16896);
    const int c = lane & 15, g = lane >> 4;
    const size_t rowq = (size_t)b * SEQ + (size_t)qt * 16;
    const bf16* PROJ = m.PROJ;
    for (int i = tid; i < 16 * 257; i += 512) hist[i] = 0u;
    for (int i = tid; i < 16 * 128; i += 512) kbq[i] = 0u;
    if (tid < 16) { s_pfx[tid] = 0u; s_k2[tid] = 0u; const int nv = qt * 16 + tid + 1; s_krem[tid] = (unsigned)(nv < 256 ? nv : 256); }
    const float WS = 0.35355339059327373f * 0.17677669529663687f * 0.5f;
    bf16x8 qf[8];
#pragma unroll
    for (int h = 0; h < 8; ++h) qf[h] = *(const bf16x8*)(PROJ + (rowq + c) * NPJ + C_IQ + h * 32 + 8 * g);
    bf16x8 ql; float wq[8];
    { const u32x4 wr = *(const u32x4*)(PROJ + (rowq + c) * NPJ + C_IW);
      wq[0] = bflo(wr.x) * WS; wq[1] = bfhi(wr.x) * WS; wq[2] = bflo(wr.y) * WS; wq[3] = bfhi(wr.y) * WS; wq[4] = bflo(wr.z) * WS; wq[5] = bfhi(wr.z) * WS; wq[6] = bflo(wr.w) * WS; wq[7] = bfhi(wr.w) * WS;
      float a[8];
#pragma unroll
      for (int j = 0; j < 8; ++j) { a[j] = 0.f;
#pragma unroll
          for (int h = 0; h < 8; ++h) a[j] += wq[h] * bf2f((unsigned short)qf[h][j]); }
      ql = pack8(a[0], a[1], a[2], a[3], a[4], a[5], a[6], a[7]); }
    const int ngrp = qt / 4 + 1, tq = qt * 16 + c;
    unsigned sc[8][4][4];
#pragma unroll
    for (int slot = 0; slot < 8; ++slot) {
        const int g64 = slot * 8 + wave;
        if (g64 < ngrp) {
#pragma unroll
            for (int j = 0; j < 4; ++j) { const int key0 = (g64 * 4 + j) * 16;
                const bf16x8 kf = *(const bf16x8*)(PROJ + ((size_t)b * SEQ + key0 + c) * NPJ + C_IK + 8 * g);
                f32x4 acc = __builtin_amdgcn_mfma_f32_16x16x32_bf16(kf, ql, (f32x4){0.f, 0.f, 0.f, 0.f}, 0, 0, 0);
#pragma unroll
                for (int h = 0; h < 8; ++h) { const f32x4 d = __builtin_amdgcn_mfma_f32_16x16x32_bf16(kf, qf[h], (f32x4){0.f, 0.f, 0.f, 0.f}, 0, 0, 0);
#pragma unroll
                    for (int i = 0; i < 4; ++i) acc[i] += wq[h] * __builtin_fabsf(d[i]); }
#pragma unroll
                for (int i = 0; i < 4; ++i) { const bool valid = key0 + 4 * g + i <= tq; const unsigned bits = __float_as_uint(acc[i]); const unsigned u = bits ^ ((unsigned)((int)bits >> 31) | 0x80000000u); sc[slot][j][i] = valid ? u : 0u; } }
        } else {
#pragma unroll
            for (int j = 0; j < 4; ++j)
#pragma unroll
                for (int i = 0; i < 4; ++i) sc[slot][j][i] = 0u;
        }
    }
    __syncthreads();
#pragma unroll
    for (int p = 0; p < 6; ++p) {
        const int rb = p & 1, wb = rb ^ 1;
        const unsigned pf = s_pfx[rb * 16 + c], k2p = s_k2[rb * 16 + c];
#pragma unroll
        for (int slot = 0; slot < 8; ++slot) {
            const int g64 = slot * 8 + wave;
            if (g64 < ngrp) {
#pragma unroll
                for (int j = 0; j < 4; ++j)
#pragma unroll
                    for (int i = 0; i < 4; ++i) { const unsigned u = sc[slot][j][i]; const unsigned key2 = 4095u - (unsigned)((g64 * 4 + j) * 16 + 4 * g + i);
                        bool part; unsigned bin;
                        if (p == 0) { part = u != 0u; bin = u >> 24; }
                        else if (p < 4) { const int sh = 24 - 8 * p; part = (u != 0u) && ((u >> (sh + 8)) == (pf >> (sh + 8))); bin = (u >> sh) & 255u; }
                        else if (p == 4) { part = (u != 0u) && (u == pf); bin = key2 >> 4; }
                        else { part = (u != 0u) && (u == pf) && ((key2 >> 4) == (k2p >> 4)); bin = key2 & 15u; }
                        if (part) (void)__hip_atomic_fetch_add(&hist[c * 257 + bin], 1u, __ATOMIC_RELAXED, __HIP_MEMORY_SCOPE_WORKGROUP); }
            }
        }
        __syncthreads();
        { const int qq = tid >> 5, jj = tid & 31; const unsigned krem = s_krem[rb * 16 + qq];
          unsigned h8[8]; unsigned csum = 0u;
#pragma unroll
          for (int k = 0; k < 8; ++k) { h8[k] = hist[qq * 257 + 255 - 8 * jj - k]; csum += h8[k]; }
          unsigned incl = csum;
#pragma unroll
          for (int o = 1; o < 32; o <<= 1) { const unsigned v = __shfl_up(incl, o, 32); if (jj >= o) incl += v; }
          const unsigned excl = incl - csum;
          if (excl < krem && krem <= incl) { unsigned run = excl, bin = 0u, newk = 0u; bool done = false;
#pragma unroll
              for (int k = 0; k < 8; ++k) { if (!done) { if (run + h8[k] >= krem) { bin = (unsigned)(255 - 8 * jj - k); newk = krem - run; done = true; } else run += h8[k]; } }
              const unsigned op = s_pfx[rb * 16 + qq], ok2 = s_k2[rb * 16 + qq];
              if (p < 4) { s_pfx[wb * 16 + qq] = op | (bin << (24 - 8 * (p < 4 ? p : 0))); s_k2[wb * 16 + qq] = 0u; }
              else if (p == 4) { s_pfx[wb * 16 + qq] = op; s_k2[wb * 16 + qq] = bin << 4; }
              else { s_pfx[wb * 16 + qq] = op; s_k2[wb * 16 + qq] = ok2 | bin; }
              s_krem[wb * 16 + qq] = newk; }
#pragma unroll
          for (int k = 0; k < 8; ++k) hist[qq * 257 + 255 - 8 * jj - k] = 0u;
        }
        __syncthreads();
    }
    { const unsigned thr = s_pfx[c], tk2 = s_k2[c];
#pragma unroll
      for (int slot = 0; slot < 8; ++slot) {
          const int g64 = slot * 8 + wave;
          if (g64 < ngrp) {
#pragma unroll
              for (int j = 0; j < 4; ++j)
#pragma unroll
                  for (int i = 0; i < 4; ++i) { const unsigned u = sc[slot][j][i]; const int key = (g64 * 4 + j) * 16 + 4 * g + i; const unsigned key2 = 4095u - (unsigned)key;
                      const bool sel = (u > thr) || (u == thr && u != 0u && key2 >= tk2);
                      if (sel) (void)__hip_atomic_fetch_or(&kbq[c * 128 + (key >> 5)], 1u << (key & 31), __ATOMIC_RELAXED, __HIP_MEMORY_SCOPE_WORKGROUP); }
          }
      }
    }
    __syncthreads();
    for (int idx = tid; idx < 16 * ngrp; idx += 512) { const int qq = idx & 15, gg = idx >> 4;
        *(u32x2*)(m.MASKQ + (rowq + qq) * 256 + 4 * gg) = *(const LAS u32x2*)(kbq + qq * 128 + 2 * gg); }
    __syncthreads();
}

__device__ __forceinline__ void attn_unit(const MixArgs& m, LAS unsigned char* lds, int tid, int wave, int lane, int b, int h, int qb) {
    LAS bf16* Ks = (LAS bf16*)lds;
    LAS bf16* Vs = (LAS bf16*)(lds + 18432);
    LAS float* btab = (LAS float*)(lds + 36864);
    const int r32 = lane & 31, hi = lane >> 5;
    if (tid < 129) btab[tid] = m.rel_bias[(int)T5BUCKET[tid] * 8 + h] * LOG2E;
    const float bfar = m.rel_bias[31 * 8 + h] * LOG2E;
    const float C2 = 0.125f * LOG2E;
    const int q0w = qb * 256 + 32 * wave;
    const size_t rowq = (size_t)b * SEQ + q0w + r32;
    bf16x8 qf[4];
#pragma unroll
    for (int ds = 0; ds < 4; ++ds) qf[ds] = *(const bf16x8*)(m.PROJ + rowq * NPJ + C_AQ + h * 64 + 16 * ds + 8 * hi);
    const int NT = 4 * qb + 4, tw = 4 * qb + (wave >> 1);
    const int srow = tid >> 3, sch = tid & 7;
    const bf16* kptr = m.PROJ + ((size_t)b * SEQ + srow) * NPJ + C_AK + h * 64 + 8 * sch;
    const bf16* vptr = m.VT + (size_t)(h * 64 + srow) * T + (size_t)b * SEQ + 8 * sch;
    u32x4 kr = *(const u32x4*)kptr, vr = *(const u32x4*)vptr;
    *(LAS u32x4*)(Ks + srow * 72 + 8 * sch) = kr; *(LAS u32x4*)(Vs + srow * 72 + 8 * sch) = vr;
    __syncthreads();
    float m_run = -INFINITY, l_run = 0.f; f32x16 o[2];
#pragma unroll
    for (int r = 0; r < 16; ++r) { o[0][r] = 0.f; o[1][r] = 0.f; }
    const unsigned long long* mrow = (const unsigned long long*)(m.MASKQ + rowq * 256);
    for (int t = 0; t < NT; ++t) {
        const int buf = t & 1;
        if (t + 1 < NT) { kr = *(const u32x4*)(kptr + (size_t)(t + 1) * 64 * NPJ); vr = *(const u32x4*)(vptr + (t + 1) * 64); }
        if (t <= tw) {
            const unsigned long long mw = mrow[t] >> (4 * hi);
            const unsigned mlo = (unsigned)mw, mhi = (unsigned)(mw >> 32);
            f32x16 p[2];
#pragma unroll
            for (int hh = 0; hh < 2; ++hh) {
#pragma unroll
                for (int r = 0; r < 16; ++r) p[hh][r] = 0.f;
#pragma unroll
                for (int ds = 0; ds < 4; ++ds) { const bf16x8 kf = *(const LAS bf16x8*)(Ks + buf * 4608 + (32 * hh + r32) * 72 + 16 * ds + 8 * hi);
                    p[hh] = __builtin_amdgcn_mfma_f32_32x32x16_bf16(kf, qf[ds], p[hh], 0, 0, 0); }
            }
            const bool near = (q0w - (64 * t + 63)) < 128;
            float mx = -INFINITY;
#pragma unroll
            for (int hh = 0; hh < 2; ++hh) { const int dbase = q0w + r32 - (64 * t + 32 * hh + 4 * hi); const unsigned mword = hh ? mhi : mlo;
#pragma unroll
                for (int r = 0; r < 16; ++r) { const int cpos = (r & 3) + 8 * (r >> 2);
                    float bias = bfar;
                    if (near) { int dd = dbase - cpos; dd = dd < 0 ? 0 : (dd > 128 ? 128 : dd); bias = btab[dd]; }
                    float s = p[hh][r] * C2 + bias; s = ((mword >> cpos) & 1u) ? s : -INFINITY; p[hh][r] = s; mx = fmaxf(mx, s); } }
            mx = fmaxf(mx, __shfl_xor(mx, 32));
            const float m_new = fmaxf(m_run, mx); const float msafe = (m_new == -INFINITY) ? 0.f : m_new;
            const float alpha = __builtin_amdgcn_exp2f(m_run - msafe); m_run = m_new;
            float rs = 0.f;
#pragma unroll
            for (int hh = 0; hh < 2; ++hh)
#pragma unroll
                for (int r = 0; r < 16; ++r) { const float e = __builtin_amdgcn_exp2f(p[hh][r] - msafe); p[hh][r] = e; rs += e; }
            l_run = l_run * alpha + rs;
#pragma unroll
            for (int r = 0; r < 16; ++r) { o[0][r] *= alpha; o[1][r] *= alpha; }
#pragma unroll
            for (int ks = 0; ks < 4; ++ks) { const int hh = ks >> 1, s2 = ks & 1;
                const bf16x8 pb = pack8(p[hh][8 * s2 + 0], p[hh][8 * s2 + 1], p[hh][8 * s2 + 2], p[hh][8 * s2 + 3], p[hh][8 * s2 + 4], p[hh][8 * s2 + 5], p[hh][8 * s2 + 6], p[hh][8 * s2 + 7]);
#pragma unroll
                for (int dh = 0; dh < 2; ++dh) { const LAS bf16* vp = Vs + buf * 4608 + (32 * dh + r32) * 72 + 32 * hh + 16 * s2 + 4 * hi;
                    const u32x2 v0 = *(const LAS u32x2*)vp, v1 = *(const LAS u32x2*)(vp + 8);
                    u32x4 vw; vw.x = v0.x; vw.y = v0.y; vw.z = v1.x; vw.w = v1.y;
                    o[dh] = __builtin_amdgcn_mfma_f32_32x32x16_bf16(__builtin_bit_cast(bf16x8, vw), pb, o[dh], 0, 0, 0); } }
        }
        if (t + 1 < NT) { *(LAS u32x4*)(Ks + (buf ^ 1) * 4608 + srow * 72 + 8 * sch) = kr; *(LAS u32x4*)(Vs + (buf ^ 1) * 4608 + srow * 72 + 8 * sch) = vr; }
        __syncthreads();
    }
    const float lt = l_run + __shfl_xor(l_run, 32); const float inv = 1.0f / lt;
    bf16* orow = m.YA + rowq * 512 + h * 64;
#pragma unroll
    for (int dh = 0; dh < 2; ++dh)
#pragma unroll
        for (int a = 0; a < 4; ++a) { u32x2 w; w.x = cvt_pk_bf16(o[dh][4 * a] * inv, o[dh][4 * a + 1] * inv); w.y = cvt_pk_bf16(o[dh][4 * a + 2] * inv, o[dh][4 * a + 3] * inv);
            *(u32x2*)(orow + 32 * dh + 8 * a + 4 * hi) = w; }
    __syncthreads();
}

template <bool OUT> __device__ __forceinline__ void hgrn_unit(const MixArgs& m, LAS unsigned char* lds, int tid, int wave, int lane, int b, int h, int c) {
    LAS bf16* QT = (LAS bf16*)lds;
    LAS bf16* KH = (LAS bf16*)(lds + 4352);
    LAS bf16* KT = (LAS bf16*)(lds + 8704);
    LAS bf16* VTL = (LAS bf16*)(lds + 12800);
    LAS float* DEC = (LAS float*)(lds + 16896);
    LAS float* PART = (LAS float*)(lds + 17408);
    LAS float* OBUF = (LAS float*)(lds + 19456);
    const bf16* PROJ = m.PROJ;
    const int d = tid & 127, tq = tid >> 7;
    const int c16 = lane & 15, g = lane >> 4;
    const int bh = b * 4 + h;
    const float lbv = sigmoidf_(m.lb_logits[h * 128 + d] - m.lb_logits[512 + h * 128 + d]);
    float Btot = 0.f;
    f32x4 st[8];
#pragma unroll
    for (int dt = 0; dt < 8; ++dt) st[dt] = (f32x4){0.f, 0.f, 0.f, 0.f};
    if (OUT) {
        const int e = 16 * wave + c16;
        for (int j = 0; j < c; ++j) { const float* U = m.HU + (size_t)(bh * 16 + j) * 16384; const float* Dj = m.HD + (size_t)(bh * 16 + j) * 128;
#pragma unroll
            for (int dt = 0; dt < 8; ++dt) { const f32x4 dv = *(const f32x4*)(Dj + 16 * dt + 4 * g);
#pragma unroll
                for (int i = 0; i < 4; ++i) st[dt][i] = dv[i] * st[dt][i] + U[(size_t)(16 * dt + 4 * g + i) * 128 + e]; } }
    }
    for (int s16 = 0; s16 < 16; ++s16) {
        const size_t row0 = (size_t)b * SEQ + (size_t)c * 256 + s16 * 16;
        float gl[4], kk[4], qs[4], cum[4]; unsigned short vraw[4];
#pragma unroll
        for (int k = 0; k < 4; ++k) { const bf16* pr = PROJ + (row0 + 4 * tq + k) * NPJ + h * 128 + d;
            const float fr = bf2f(pr[C_BF]), qr = bf2f(pr[C_BQ]); vraw[k] = pr[C_BI];
            const float f = lbv + (1.f - lbv) * sigmoidf_(fr); gl[k] = __logf(f); kk[k] = 1.f - f; qs[k] = qr * sigmoidf_(qr) * 0.08838834764831845f; }
        cum[0] = gl[0]; cum[1] = cum[0] + gl[1]; cum[2] = cum[1] + gl[2]; cum[3] = cum[2] + gl[3];
        PART[tq * 128 + d] = cum[3];
        { u32x2 w; w.x = (unsigned)vraw[0] | ((unsigned)vraw[1] << 16); w.y = (unsigned)vraw[2] | ((unsigned)vraw[3] << 16); *(LAS u32x2*)(VTL + d * 16 + 4 * tq) = w; }
        __syncthreads();
        float off = 0.f, tot = 0.f;
#pragma unroll
        for (int q = 0; q < 4; ++q) { const float pv = PART[q * 128 + d]; tot += pv; if (q < tq) off += pv; }
        float kt4[4];
#pragma unroll
        for (int k = 0; k < 4; ++k) { const float Bt = off + cum[k]; const int tt = 4 * tq + k;
            QT[tt * 136 + d] = (bf16)(cvt_pk_bf16(qs[k] * __expf(Bt), 0.f) & 0xffffu);
            KH[tt * 136 + d] = (bf16)(cvt_pk_bf16(kk[k] * __expf(-Bt), 0.f) & 0xffffu);
            kt4[k] = kk[k] * __expf(tot - Bt); }
        { u32x2 w; w.x = cvt_pk_bf16(kt4[0], kt4[1]); w.y = cvt_pk_bf16(kt4[2], kt4[3]); *(LAS u32x2*)(KT + d * 16 + 4 * tq) = w; }
        if (tq == 0) { DEC[d] = __expf(tot); Btot += tot; }
        __syncthreads();
        const bf16x8 bv = lo4(*(const LAS u32x2*)(VTL + (16 * wave + c16) * 16 + 4 * g));
        if (OUT) {
            f32x4 acc = (f32x4){0.f, 0.f, 0.f, 0.f}, aT = (f32x4){0.f, 0.f, 0.f, 0.f};
#pragma unroll
            for (int ks = 0; ks < 4; ++ks) {
                const u32x2 a0 = *(const LAS u32x2*)(QT + c16 * 136 + 32 * ks + 4 * g), a1 = *(const LAS u32x2*)(QT + c16 * 136 + 32 * ks + 16 + 4 * g);
                u32x4 aw; aw.x = a0.x; aw.y = a0.y; aw.z = a1.x; aw.w = a1.y;
                const bf16x8 sb = pack8(st[2 * ks][0], st[2 * ks][1], st[2 * ks][2], st[2 * ks][3], st[2 * ks + 1][0], st[2 * ks + 1][1], st[2 * ks + 1][2], st[2 * ks + 1][3]);
                acc = __builtin_amdgcn_mfma_f32_16x16x32_bf16(__builtin_bit_cast(bf16x8, aw), sb, acc, 0, 0, 0);
                const bf16x8 kh = *(const LAS bf16x8*)(KH + c16 * 136 + 32 * ks + 8 * g), qn = *(const LAS bf16x8*)(QT + c16 * 136 + 32 * ks + 8 * g);
                aT = __builtin_amdgcn_mfma_f32_16x16x32_bf16(kh, qn, aT, 0, 0, 0);
            }
#pragma unroll
            for (int i = 0; i < 4; ++i) if (4 * g + i > c16) aT[i] = 0.f;
            const bf16x8 aa = pack8(aT[0], aT[1], aT[2], aT[3], 0.f, 0.f, 0.f, 0.f);
            acc = __builtin_amdgcn_mfma_f32_16x16x32_bf16(aa, bv, acc, 0, 0, 0);
#pragma unroll
            for (int i = 0; i < 4; ++i) OBUF[(4 * g + i) * 132 + 16 * wave + c16] = acc[i];
        }
#pragma unroll
        for (int dt = 0; dt < 8; ++dt) { const bf16x8 ka = lo4(*(const LAS u32x2*)(KT + (16 * dt + c16) * 16 + 4 * g)); const f32x4 dv = *(const LAS f32x4*)(DEC + 16 * dt + 4 * g);
            st[dt] = __builtin_amdgcn_mfma_f32_16x16x32_bf16(ka, bv, st[dt] * dv, 0, 0, 0); }
        __syncthreads();
        if (OUT) {
#pragma unroll 1
            for (int q = 0; q < 2; ++q) { const int t = 2 * wave + q; const float o0 = OBUF[t * 132 + lane], o1 = OBUF[t * 132 + 64 + lane];
                const float rstd = rsqrtf(wave_sum(o0 * o0 + o1 * o1) * (1.f / 128.f) + EPS);
                const bf16* pg = PROJ + (row0 + t) * NPJ + C_BG + h * 128; const float g0 = bf2f(pg[lane]), g1 = bf2f(pg[64 + lane]);
                const float y0 = o0 * rstd * m.hgrn_norm[h * 128 + lane] * g0 * sigmoidf_(g0), y1 = o1 * rstd * m.hgrn_norm[h * 128 + 64 + lane] * g1 * sigmoidf_(g1);
                bf16* yo = m.YB + (row0 + t) * 512 + h * 128;
                yo[lane] = (bf16)(cvt_pk_bf16(y0, 0.f) & 0xffffu); yo[64 + lane] = (bf16)(cvt_pk_bf16(y1, 0.f) & 0xffffu); }
        }
    }
    if (!OUT) {
        const int e = 16 * wave + c16; float* U = m.HU + (size_t)(bh * 16 + c) * 16384;
#pragma unroll
        for (int dt = 0; dt < 8; ++dt)
#pragma unroll
            for (int i = 0; i < 4; ++i) U[(size_t)(16 * dt + 4 * g + i) * 128 + e] = st[dt][i];
        if (tq == 0) m.HD[(size_t)(bh * 16 + c) * 128 + d] = __expf(Btot);
    }
    __syncthreads();
}

__device__ __forceinline__ MixArgs make_mix(const Args& args) {
    unsigned char* ws = args.ws;
    return MixArgs{(const bf16*)(ws + WS_PROJ), (const bf16*)(ws + WS_VT), (unsigned short*)(ws + WS_MASK), (bf16*)(ws + WS_YA), (bf16*)(ws + WS_YB), (float*)(ws + WS_HU), (float*)(ws + WS_HD), args.in[8], args.in[9], args.in[10]};
}
__device__ __forceinline__ void p2_phase(const Args& args, LAS unsigned char* lds, int tid, int wave, int lane, int bx, int G) {
    const MixArgs m = make_mix(args);
#define PIDX_ROUND(r) { const int k = ((r) & 1) ? (G - 1 - bx) : bx; const int u = (r) * G + k; if (u < 2048) pidx_unit(m, lds, tid, wave, lane, u & 7, 255 - (u >> 3)); }
    PIDX_ROUND(0) PIDX_ROUND(1) PIDX_ROUND(2) PIDX_ROUND(3) PIDX_ROUND(4) PIDX_ROUND(5) PIDX_ROUND(6) PIDX_ROUND(7)
#undef PIDX_ROUND
    for (int u = bx; u < 480; u += G) { const int bh = u / 15, c = u % 15; hgrn_unit<false>(m, lds, tid, wave, lane, bh >> 2, bh & 3, c); }
}
__device__ __forceinline__ void p3_phase(const Args& args, LAS unsigned char* lds, int tid, int wave, int lane, int bx, int G) {
    const MixArgs m = make_mix(args);
    int round = 0;
    for (int base = 0; base < 1024; base += G, ++round) { const int k = (round & 1) ? (G - 1 - bx) : bx; const int u = base + k; if (u < 1024) { const int qb = 15 - (u >> 6), bhh = u & 63; attn_unit(m, lds, tid, wave, lane, bhh >> 3, bhh & 7, qb); } }
    for (int u = bx; u < 512; u += G) { const int bh = u >> 4, c = u & 15; hgrn_unit<true>(m, lds, tid, wave, lane, bh >> 2, bh & 3, 15 - c); }
}

__global__ void __launch_bounds__(512, 2) mk_fwd(Args args) {
    extern __shared__ __attribute__((aligned(16))) unsigned char lds_raw[];
    LAS unsigned char* lds = (LAS unsigned char*)lds_raw;
    volatile LAS unsigned* MISC = (volatile LAS unsigned*)(lds + MISC_OFF);
    const int tid = threadIdx.x, lane = tid & 63, wave = __builtin_amdgcn_readfirstlane(tid >> 6);
    const int G = gridDim.x; const int bx = blockIdx.x; const int vcu = (G % 8 == 0) ? (bx % 8) * (G / 8) + bx / 8 : bx;
    unsigned char* ws = args.ws;
    unsigned* ctl = (unsigned*)(ws + WS_CTL);
    for (int u = tid; u < (LDS_BYTES - RING_BYTES) / 4; u += 512) ((LAS unsigned*)(lds + RING_BYTES))[u] = 0u;
    __syncthreads();
    XcdBarrier bar; bar.bar = ctl + CW_BAR; bar.x = 0; bar.st = nullptr;
    if (MK_N_LAUNCHES == 1) bar = xcd_barrier_post(ctl + CW_BAR, MISC + 8);
    const int lo = args.ph_lo, hi = args.ph_hi;
#define IN(k) (lo <= (k) && (k) < hi)
#define SEAM(k) do { if (IN(k) && IN((k) + 1)) xcd_barrier(bar); } while (0)

    bf16* const WIN = (bf16*)(ws + WS_WIN); bf16* const WV = (bf16*)(ws + WS_WV); bf16* const WUA = (bf16*)(ws + WS_WUA); bf16* const WUB = (bf16*)(ws + WS_WUB);
    bf16* const WO = (bf16*)(ws + WS_WO); bf16* const WGU = (bf16*)(ws + WS_WGU); bf16* const WDN = (bf16*)(ws + WS_WDN);
    bf16* const XN = (bf16*)(ws + WS_XN); bf16* const PROJ = (bf16*)(ws + WS_PROJ); bf16* const VT = (bf16*)(ws + WS_VT);
    bf16* const YA = (bf16*)(ws + WS_YA); bf16* const YB = (bf16*)(ws + WS_YB); bf16* const MRG = (bf16*)(ws + WS_MRG);
    bf16* const ACT = (bf16*)(ws + WS_ACT); bf16* const YEXP = (bf16*)(ws + WS_YEXP);
    int* const TOKL = (int*)(ws + WS_TOKL); u32x2* const TOKI = (u32x2*)(ws + WS_TOKI);
    unsigned* const CNT = ctl + CW_CNT;

    if (IN(0)) {
        P0Args a{args.in[0], args.in[1], args.in[2], args.in[3], args.in[4], args.in[5], args.in[13], args.in[15], ws};
        p0_prologue(a, lds, wave, lane, vcu, G);
    }
    SEAM(0);
    if (IN(1)) {
        { pg8::StaticSched S; S.init(XN, WIN, T, NPJ, DM, G, bx); pg8::EpiBf16 E{PROJ, NPJ, nullptr, 0}; pg8::gemm_phase(lds, DM, S, E); }
        { pg8::StaticSched S; S.init(WV, XN, 512, T, DM, G, bx); pg8::EpiBf16 E{VT, T, nullptr, 0}; pg8::gemm_phase(lds, DM, S, E); }
    }
    SEAM(1);
    if (IN(2)) {
#ifdef HAVE_MIX
        p2_phase(args, lds, tid, wave, lane, bx, G);
#endif
    }
    SEAM(2);
    if (IN(3)) {
#ifdef HAVE_MIX
        p3_phase(args, lds, tid, wave, lane, bx, G);
#endif
    }
    SEAM(3);
#ifndef DBG_NOMIX
    if (IN(4)) {
        { pg8::StaticSched S; S.init(YA, WUA, T, DM, 512, G, bx); pg8::EpiMerge<true> E{PROJ + C_GA, MRG}; pg8::gemm_phase(lds, 512, S, E); }
        { pg8::StaticSched S; S.init(YB, WUB, T, DM, 512, G, bx); pg8::EpiMerge<false> E{PROJ + C_GB, MRG}; pg8::gemm_phase(lds, 512, S, E); }
    }
#ifndef DBG_NOMIX
    SEAM(4);
#endif
    if (IN(5)) {
        pg8::StaticSched S; S.init(MRG, WO, T, DM, DM, G, bx); pg8::EpiOutRes E{args.in[0], args.out}; pg8::gemm_phase(lds, DM, S, E);
    }
#else
    SEAM(4);
    if (IN(5)) { for (int m = vcu * 8 + wave; m < T; m += G * 8) { const f32x4* xr = (const f32x4*)(args.in[0] + (size_t)m * DM) + lane; f32x4* orow = (f32x4*)(args.out + (size_t)m * DM) + lane;
        for (int j = 0; j < 4; ++j) orow[64 * j] = xr[64 * j]; } }
#endif
    SEAM(5);
    if (IN(6)) {
        P6Args a{args.out, args.in[6], args.in[11], args.in[12], XN, CNT, TOKL, TOKI};
        p6_router(a, lds, tid, wave, lane, vcu, G);
    }
    SEAM(6);
    if (IN(7) || IN(8)) {
        LAS int* tstart = (LAS int*)(lds + RING_BYTES + 16);
        if (tid == 0) { int acc = 0; for (int e = 0; e < NEXP; ++e) { tstart[e] = acc; acc += ((int)__hip_atomic_load(CNT + 16 * e, __ATOMIC_RELAXED, __HIP_MEMORY_SCOPE_AGENT) + 255) / 256; } tstart[NEXP] = acc; }
        __syncthreads();
        if (IN(7)) {
            pg8::MoeSched<true> S{XN, WGU, TOKL, (const int*)CNT, tstart, DM, 8, 2 * DFF, G, bx};
            pg8::EpiSwiGLU E{args.in[14], ACT}; pg8::gemm_phase(lds, DM, S, E);
        }
        SEAM(7);
        if (IN(8)) {
            pg8::MoeSched<false> S{ACT, WDN, TOKL, (const int*)CNT, tstart, DFF, 4, DM, G, bx};
            pg8::EpiBf16 E{YEXP, DM, args.in[16], DM}; pg8::gemm_phase(lds, DFF, S, E);
        }
    }
    SEAM(8);
    if (IN(9)) p9_final(args.out, YEXP, TOKI, CNT, args.in[7], lds, tid, wave, lane, vcu, G);
#undef IN
#undef SEAM
}

#if DBG_STAGE >= 0
__device__ __forceinline__ float block_sum256(float v, float* sh) {
    v = wave_sum(v); if ((threadIdx.x & 63) == 0) sh[threadIdx.x >> 6] = v; __syncthreads();
    float r = 0.f; for (int i = 0; i < (int)(blockDim.x >> 6); ++i) r += sh[i]; __syncthreads(); return r;
}
__device__ __forceinline__ void dbg_report(unsigned* ctl, float err) { if (threadIdx.x == 0) atomicMax(ctl + CW_DBG, __float_as_uint(fabsf(err))); }
__global__ void dbg_fill(float* out, const unsigned* ctl) {
    const float e = __uint_as_float(ctl[CW_DBG]); const float K = 10.f * sqrtf(fminf(e, 1e4f));
    for (size_t i = (size_t)blockIdx.x * blockDim.x + threadIdx.x; i < (size_t)T * DM; i += (size_t)gridDim.x * blockDim.x) out[i] = K;
}
__global__ void dbg_check1(Args a) {
    __shared__ float sh[8];
    const unsigned s = blockIdx.x; const int row = (int)((s * 2654435761u) % (unsigned)T); const int tid = threadIdx.x;
    const float* x = a.in[0] + (size_t)row * DM; const float* g = a.in[5]; const float* w = a.in[1];
    float ss = 0.f; for (int k = tid; k < DM; k += 256) ss += x[k] * x[k];
    ss = block_sum256(ss, sh); const float rstd = rsqrtf(ss / DM + EPS);
    const bool isv = (s & 7) == 7; int n, sc;
    if (isv) { n = (int)((s * 40503u + 17u) % 512u); sc = 1024 + n; } else { n = (int)((s * 40503u + 17u) % 5416u); sc = srccol_in(n); }
    float acc = 0.f; for (int k = tid; k < DM; k += 256) acc += x[k] * rstd * g[k] * w[(size_t)k * 5928 + sc];
    acc = block_sum256(acc, sh);
    const bf16* PROJ = (const bf16*)(a.ws + WS_PROJ); const bf16* VT = (const bf16*)(a.ws + WS_VT);
    const float got = isv ? bf2f(VT[(size_t)n * T + row]) : bf2f(PROJ[(size_t)row * NPJ + n]);
    dbg_report((unsigned*)(a.ws + WS_CTL), got - acc);
}
__global__ void dbg_check9(Args a) {
    __shared__ float h2[1024], gu[2048], act[1024], ysum[1024], lg[32], gt[4], sh[8]; __shared__ int te[4];
    const unsigned s = blockIdx.x; const int t = (int)((s * 2654435761u) % (unsigned)T); const int tid = threadIdx.x;
    const float* x = a.in[0] + (size_t)t * DM;
    float ss = 0.f; for (int k = tid; k < DM; k += 256) ss += x[k] * x[k];
    ss = block_sum256(ss, sh); const float rstd = rsqrtf(ss / DM + EPS);
    for (int k = tid; k < DM; k += 256) { h2[k] = x[k] * rstd * a.in[6][k]; ysum[k] = 0.f; }
    __syncthreads();
    if (tid < 32) { float acc = 0.f; for (int k = 0; k < DM; ++k) acc += h2[k] * a.in[11][(size_t)k * 32 + tid]; lg[tid] = acc + a.in[12][tid]; }
    __syncthreads();
    if (tid == 0) { float v[32]; for (int e = 0; e < 32; ++e) v[e] = lg[e]; float tv[4];
        for (int k = 0; k < 4; ++k) { int be = 0; for (int e = 1; e < 32; ++e) if (lg[e] > lg[be]) be = e; te[k] = be; tv[k] = lg[be]; lg[be] = -INFINITY; }
        float den = 0.f; for (int k = 0; k < 4; ++k) den += expf(tv[k] - tv[0]); for (int k = 0; k < 4; ++k) gt[k] = expf(tv[k] - tv[0]) / den; (void)v; }
    __syncthreads();
    for (int k4 = 0; k4 < 4; ++k4) { const int e = te[k4];
        const float* wg = a.in[13] + (size_t)e * DM * 2048; const float* wd = a.in[15] + (size_t)e * DFF * DM;
        for (int n = tid; n < 2048; n += 256) { float acc = 0.f; for (int k = 0; k < DM; ++k) acc += h2[k] * wg[(size_t)k * 2048 + n]; gu[n] = acc + a.in[14][e * 2048 + n]; }
        __syncthreads();
        for (int j = tid; j < DFF; j += 256) { const float g = fminf(gu[j], 7.f), l = fminf(fmaxf(gu[1024 + j], -7.f), 7.f); act[j] = (l + 1.f) * g / (1.f + expf(-1.702f * g)); }
        __syncthreads();
        for (int n = tid; n < DM; n += 256) { float acc = 0.f; for (int j = 0; j < DFF; ++j) acc += act[j] * wd[(size_t)j * DM + n]; ysum[n] += gt[k4] * (acc + a.in[16][e * DM + n]); }
        __syncthreads();
    }
    float s2 = 0.f; for (int k = tid; k < DM; k += 256) { const float v = x[k] + ysum[k]; s2 += v * v; }
    s2 = block_sum256(s2, sh); const float r2 = rsqrtf(s2 / DM + EPS);
    float me = 0.f; for (int k = tid; k < DM; k += 256) { const float ref = (x[k] + ysum[k]) * r2 * a.in[7][k]; me = fmaxf(me, fabsf(a.out[(size_t)t * DM + k] - ref)); }
    atomicMax((unsigned*)(a.ws + WS_CTL) + CW_DBG, __float_as_uint(me));
}
#if DBG_STAGE == 1
#define DBG_KERNEL dbg_check1
#elif DBG_STAGE == 9
#define DBG_KERNEL dbg_check9
#endif
static void dbg_launch(Args a, hipStream_t stream) {
    hipLaunchKernelGGL(DBG_KERNEL, dim3(256), dim3(256), 0, stream, a);
    hipLaunchKernelGGL(dbg_fill, dim3(2048), dim3(256), 0, stream, a.out, (const unsigned*)(a.ws + WS_CTL));
}
#endif

extern "C" void kernel_launch(void* const* d_in, const int* in_sizes, int n_in, void* d_out, int out_size, void* d_ws, size_t ws_size, hipStream_t stream) {
    static int grid = 0;
    if (grid == 0) {
        if (n_in != 17 || out_size != T * DM || ws_size < WS_END) { fprintf(stderr, "kernel_launch: unexpected shapes (n_in %d out %d ws %zu, need %zu)\n", n_in, out_size, ws_size, (size_t)WS_END); grid = -1; return; }
        int dev = 0, cus = 0, per_cu = 0;
        if (hipGetDevice(&dev) != hipSuccess || hipDeviceGetAttribute(&cus, hipDeviceAttributeMultiprocessorCount, dev) != hipSuccess) { grid = -1; return; }
        if (hipFuncSetAttribute((const void*)mk_fwd, hipFuncAttributeMaxDynamicSharedMemorySize, LDS_BYTES) != hipSuccess) { fprintf(stderr, "kernel_launch: hipFuncSetAttribute failed\n"); grid = -1; return; }
        if (hipOccupancyMaxActiveBlocksPerMultiprocessor(&per_cu, (const void*)mk_fwd, 512, LDS_BYTES) != hipSuccess || per_cu < 1) fprintf(stderr, "kernel_launch: occupancy query says %d\n", per_cu);
        (void)hipGetLastError();
        grid = cus;
    }
    if (grid < 0) return;
    (void)hipMemsetAsync((char*)d_ws + WS_CTL, 0, CTL_ZERO_BYTES, stream);
    Args a{};
    for (int i = 0; i < 17; ++i) a.in[i] = (const float*)d_in[i];
    a.out = (float*)d_out; a.ws = (unsigned char*)d_ws;
#if DBG_STAGE >= 0
    const int last = DBG_STAGE + 1;
#else
    const int last = NPHASE;
#endif
    if (MK_N_LAUNCHES == 1) { a.ph_lo = 0; a.ph_hi = last; hipLaunchKernelGGL(mk_fwd, dim3(grid), dim3(512), LDS_BYTES, stream, a); }
    else for (int p = 0; p < last; ++p) { a.ph_lo = p; a.ph_hi = p + 1; hipLaunchKernelGGL(mk_fwd, dim3(grid), dim3(512), LDS_BYTES, stream, a); }
#if DBG_STAGE >= 0
    dbg_launch(a, stream);
#endif
}
```

```cpp
#include <hip/hip_runtime.h>
#include <cstdio>
#include <cstdint>

#ifndef MK_N_LAUNCHES
#define MK_N_LAUNCHES 1
#endif
#ifndef DBG_STAGE
#define DBG_STAGE -1
#endif

#define GAS __attribute__((address_space(1)))
#define LAS __attribute__((address_space(3)))
typedef unsigned short bf16;
typedef short bf16x8 __attribute__((ext_vector_type(8)));
typedef short s16x4 __attribute__((ext_vector_type(4)));
typedef float f32x2 __attribute__((ext_vector_type(2)));
typedef float f32x4 __attribute__((ext_vector_type(4)));
typedef float f32x16 __attribute__((ext_vector_type(16)));
typedef unsigned u32x2 __attribute__((ext_vector_type(2)));
typedef unsigned u32x4 __attribute__((ext_vector_type(4)));

constexpr int BATCH = 8, SEQ = 4096, DM = 1024, T = BATCH * SEQ;
constexpr int NPJ = 5632;
constexpr int C_AQ = 0, C_AK = 512, C_IQ = 1024, C_BQ = 1280, C_BF = 1792, C_BI = 2304, C_BG = 2816, C_GA = 3328, C_GB = 4352, C_IW = 5376, C_IK = 5384;
constexpr int NEXP = 32, DFF = 1024, TOPK = 4;
constexpr float EPS = 1e-6f;
constexpr int NPHASE = 10;

constexpr size_t MiB = 1u << 20;
constexpr size_t WS_CTL = 0, CTL_ZERO_BYTES = 1 * MiB;
constexpr size_t WS_WIN = 2 * MiB, WS_WV = 13 * MiB, WS_WUA = 14 * MiB, WS_WUB = 15 * MiB, WS_WO = 16 * MiB, WS_WGU = 18 * MiB, WS_WDN = 146 * MiB;
constexpr size_t WS_TOKL = 210 * MiB, WS_TOKI = 214 * MiB, WS_XN = 216 * MiB, WS_PROJ = 280 * MiB;
constexpr size_t WS_E = 632 * MiB;
constexpr size_t WS_VT = WS_E, WS_MASK = WS_E + 32 * MiB, WS_YA = WS_E + 48 * MiB, WS_YB = WS_E + 80 * MiB, WS_MRG = WS_E + 112 * MiB, WS_HU = WS_E + 176 * MiB, WS_HD = WS_E + 208 * MiB;
constexpr size_t WS_ACT = WS_PROJ, WS_YEXP = WS_E;
constexpr size_t WS_END = 904 * MiB;
constexpr int CW_TMO = 0, CW_CODE = 1, CW_CNT = 64  , CW_DBG = 1024, CW_BAR = 4096;

constexpr int RING_BYTES = 131072, MISC_OFF = RING_BYTES + 320, LDS_BYTES = 147456;

struct Args { const float* in[17]; float* out; unsigned char* ws; int ph_lo, ph_hi; };
__device__ __forceinline__ unsigned cvt_pk_bf16(float lo, float hi) { unsigned r; asm volatile("v_cvt_pk_bf16_f32 %0, %1, %2" : "=v"(r) : "v"(lo), "v"(hi)); return r; }
__device__ __forceinline__ float bf2f(unsigned short b) { return __uint_as_float((unsigned)b << 16); }
__device__ __forceinline__ float bflo(unsigned w) { return __uint_as_float(w << 16); }
__device__ __forceinline__ float bfhi(unsigned w) { return __uint_as_float(w & 0xffff0000u); }
__device__ __forceinline__ float sigmoidf_(float x) { return __builtin_amdgcn_rcpf(1.0f + __expf(-x)); }
__device__ __forceinline__ float wave_sum(float v) {
#pragma unroll
    for (int o = 1; o < 64; o <<= 1) v += __shfl_xor(v, o);
    return v;
}
#define LDS_WAIT() asm volatile("s_waitcnt lgkmcnt(0)" ::: "memory")
#define VM_WAIT() asm volatile("s_waitcnt vmcnt(0)" ::: "memory")

#define XB_TMO      128
#define XB_XCNT(j)  (256  + 64 * (j))
#define XB_XSUB(j)  (1280 + 64 * (j))
#define XB_XGEN(j)  (2304 + 64 * (j))
#define XB_TOP      3328
#define XB_TOPGEN   3392
#define XCD_BAR_WORDS 3456
#define XB_SPIN_CAP (1u << 18)
__device__ __forceinline__ unsigned xb_ld(unsigned* p)              { return __hip_atomic_load(p, __ATOMIC_RELAXED, __HIP_MEMORY_SCOPE_AGENT); }
__device__ __forceinline__ unsigned xb_add(unsigned* p, unsigned v) { return __hip_atomic_fetch_add(p, v, __ATOMIC_RELAXED, __HIP_MEMORY_SCOPE_AGENT); }
__device__ __forceinline__ unsigned xb_xcc_id() { return (unsigned)__builtin_amdgcn_s_getreg((3 << 11) | 20) & 0xFu; }
#define XB_SPIN(cond, bar) do { unsigned _sp = 0; while (cond) { __builtin_amdgcn_s_sleep(1); \
    if ((++_sp & 255u) == 0u) { if (xb_ld(&(bar)[XB_TMO])) break; if (_sp > XB_SPIN_CAP) { atomicAdd(&(bar)[XB_TMO], 1u); break; } } } } while (0)
struct XcdBarrier { unsigned* bar; unsigned x; volatile LAS unsigned* st; };
__device__ __forceinline__ XcdBarrier xcd_barrier_post(unsigned* bar, volatile LAS unsigned* st) {
    XcdBarrier b; b.bar = bar; b.x = xb_xcc_id(); b.st = st;
    if (threadIdx.x == 0) (void)xb_add(&bar[XB_XCNT(b.x)], 1u);
    return b;
}
__device__ __forceinline__ void xcd_barrier_complete(unsigned* bar, unsigned x, unsigned& nloc, unsigned& nx) {
    const unsigned G = gridDim.x * gridDim.y * gridDim.z;
    unsigned sum, cnt, mine, sp = 0u;
    for (;;) {
        sum = 0u; cnt = 0u; mine = 0u;
#pragma unroll
        for (unsigned j = 0; j < 16; ++j) { const unsigned c = xb_ld(&bar[XB_XCNT(j)]); sum += c; cnt += (c > 0u) ? 1u : 0u; mine = (j == x) ? c : mine; }
        if (sum == G) break;
        __builtin_amdgcn_s_sleep(1);
        if ((++sp & 255u) == 0u) { if (xb_ld(&bar[XB_TMO])) break; if (sp > XB_SPIN_CAP) { atomicAdd(&bar[XB_TMO], 1u); break; } }
    }
    nloc = mine > 0u ? mine : 1u; nx = cnt > 0u ? cnt : 1u;
}
__device__ __forceinline__ void xcd_barrier(const XcdBarrier& b) {
    asm volatile("s_waitcnt vmcnt(0)" ::: "memory");
    __syncthreads();
    if (threadIdx.x == 0) {
        unsigned* bar = b.bar;
        __builtin_amdgcn_s_waitcnt(0);
        unsigned nloc = b.st[0], nx = b.st[1];
        if (nloc == 0u) { xcd_barrier_complete(bar, b.x, nloc, nx); b.st[0] = nloc; b.st[1] = nx; }
        const unsigned old = xb_add(&bar[XB_XSUB(b.x)], 1u);
        const unsigned gen = old / nloc;
        if (old + 1u == (gen + 1u) * nloc) {
            __builtin_amdgcn_fence(__ATOMIC_RELEASE, "agent");
            asm volatile("s_waitcnt vmcnt(0)" ::: "memory");
            const unsigned og = xb_add(&bar[XB_TOP], 1u);
            const unsigned tg = og / nx;
            if (og + 1u == (tg + 1u) * nx) xb_add(&bar[XB_TOPGEN], 1u);
            else XB_SPIN(xb_ld(&bar[XB_TOPGEN]) == tg, bar);
            __builtin_amdgcn_fence(__ATOMIC_ACQUIRE, "agent");
            xb_add(&bar[XB_XGEN(b.x)], 1u);
            asm volatile("s_waitcnt vmcnt(0)" ::: "memory");
        } else {
            XB_SPIN(xb_ld(&bar[XB_XGEN(b.x)]) == gen, bar);
            __builtin_amdgcn_fence(__ATOMIC_ACQUIRE, "agent");
            asm volatile("s_waitcnt vmcnt(0)" ::: "memory");
        }
    }
    __syncthreads();
}
namespace pg8 {
constexpr int BM = 256, BK = 64, HALF = 128, HTB = HALF * BK * 2, STAGE_BYTES = 8 * HTB, NXCD = 8, WGM = 8;
__host__ __device__ __forceinline__ int lds_byte(int r, int c) { const int st = (r >> 4) * 2 + (c >> 5), rr = r & 15, cc = c & 31, ob = rr * 64 + cc * 2; return st * 1024 + (ob ^ (((ob >> 9) & 1) << 5)); }
__host__ __device__ __forceinline__ void stage_rc(int b, int& R, int& C) { const int st = b / 1024, sb = b % 1024, swz = sb ^ (((sb >> 9) & 1) << 5); R = (st >> 1) * 16 + swz / 64; C = (st & 1) * 32 + (swz % 64) / 2; }
__host__ __device__ __forceinline__ int perm32(int rho) { const int n = rho >> 4, i = rho & 15; return 8 * (i >> 2) + 4 * n + (i & 3); }

struct Unit { const char* A0; const char* B0; int orow, pn, e, rt; };

struct StaticSched {
    const bf16* A; const bf16* Bt; int K, nM, nN, nwg, G, c;
    __device__ __forceinline__ void init(const bf16* A_, const bf16* Bt_, int M, int N, int K_, int G_, int c_) { A = A_; Bt = Bt_; K = K_; nM = M / BM; nN = N / BM; nwg = nM * nN; G = G_; c = c_; }
    __device__ __forceinline__ bool next(int i, Unit& u) const {
        const long L = (long)i * G + c; if (L >= nwg) return false;
        int wgid = (int)L; { const int q = nwg / NXCD, r = nwg % NXCD, xcd = wgid % NXCD, off = wgid / NXCD; wgid = (xcd < r ? xcd * (q + 1) : r * (q + 1) + (xcd - r) * q) + off; }
        const int nig = WGM * nN, gid = wgid / nig, fm = gid * WGM, gsz = (nM - fm) < WGM ? (nM - fm) : WGM;
        const int pm = fm + ((wgid % nig) % gsz), pn = (wgid % nig) / gsz;
        u.A0 = (const char*)A + (size_t)pm * BM * K * 2; u.B0 = (const char*)Bt + (size_t)pn * BM * K * 2; u.orow = pm * BM; u.pn = pn; u.e = 0; u.rt = 0; return true;
    }
    __device__ __forceinline__ void offs(const Unit&, const int (&R)[2], const int (&C)[2], unsigned (&o)[2][2]) const {
#pragma unroll
        for (int h = 0; h < 2; ++h)
#pragma unroll
            for (int i = 0; i < 2; ++i) o[h][i] = (unsigned)((h * HALF + R[i]) * K + C[i]) * 2u;
    }
};

template <bool GATHER> struct MoeSched {
    const bf16* XA; const bf16* W; const int* toklist; const int* cnt  ; const LAS int* tstart; int K, npn, nrows_w  , G, c;
    __device__ __forceinline__ bool next(int i, Unit& u) const {
        const long L = (long)i * G + c; const int ntile = tstart[NEXP];
        if (L >= (long)ntile * npn) return false;
        const int rtg = (int)(L / npn), pn = (int)(L % npn);
        int e = 0;
#pragma unroll 1
        for (int k = 1; k < NEXP; ++k) e += (tstart[k] <= rtg) ? 1 : 0;
        e = __builtin_amdgcn_readfirstlane(e);
        u.e = e; u.rt = rtg - tstart[e]; u.pn = pn; u.orow = rtg * BM;
        u.A0 = GATHER ? (const char*)XA : (const char*)XA + (size_t)rtg * BM * K * 2;
        u.B0 = (const char*)W + ((size_t)e * nrows_w + (size_t)pn * BM) * K * 2;
        return true;
    }
    __device__ __forceinline__ void offs(const Unit& u, const int (&R)[2], const int (&C)[2], unsigned (&o)[2][2]) const {
        if (GATHER) {
            const int n = cnt[16 * u.e];
#pragma unroll
            for (int h = 0; h < 2; ++h)
#pragma unroll
                for (int i = 0; i < 2; ++i) { const int r = u.rt * BM + h * HALF + R[i]; const int tok = (r < n) ? toklist[u.e * T + r] : 0; o[h][i] = (unsigned)(tok * K + C[i]) * 2u; }
        } else {
#pragma unroll
            for (int h = 0; h < 2; ++h)
#pragma unroll
                for (int i = 0; i < 2; ++i) o[h][i] = (unsigned)((h * HALF + R[i]) * K + C[i]) * 2u;
        }
    }
};

template <class Epi, class Sched>
__device__ __forceinline__ void gemm_phase(LAS unsigned char* lds, const int K, const Sched& S, const Epi& E) {
    const int tid = threadIdx.x, wid = __builtin_amdgcn_readfirstlane(tid >> 6), lane = tid & 63, wr = wid >> 2, wc = wid & 3, fr = lane & 15, fq = lane >> 4;
    const int nt = K / BK;
    int Rr[2], Cc[2]; unsigned voffB[2];
#pragma unroll
    for (int i = 0; i < 2; ++i) { int R, C; stage_rc(tid * 16 + i * 8192, R, C); Rr[i] = R; Cc[i] = C; const int Rb = Epi::PERM ? ((R & ~31) + perm32(R & 31)) : R; voffB[i] = (unsigned)(Rb * K + C) * 2u; }
    const size_t kstep = (size_t)(BK * 2);
    const size_t hstep = (size_t)HALF * K * 2;
    const unsigned ldsw = (unsigned)wid * 1024u;
    const int aoff = lds_byte(wr * 64 + fr, fq * 8), boff = lds_byte(wc * 32 + fr, fq * 8);
#define PG8_SA(b, h) (((b) * 2 + (h)) * HTB)
#define PG8_SB(b, h) ((4 + (b) * 2 + (h)) * HTB)
#define PG8_STAGE(bufoff, gbase, voff) do { _Pragma("unroll") for (int _i = 0; _i < 2; ++_i) \
        __builtin_amdgcn_global_load_lds((const unsigned*)((const char*)(gbase) + (voff)[_i]), (LAS unsigned*)(lds + (bufoff) + ldsw + _i * 8192), 16, 0, 0); } while (0)
#define PG8_LDA(dst, b, h) do { _Pragma("unroll") for (int m = 0; m < 4; ++m) _Pragma("unroll") for (int k = 0; k < 2; ++k) dst[m][k] = *(const LAS bf16x8*)(lds + PG8_SA(b, h) + aoff + m * 2048 + k * 1024); } while (0)
#define PG8_LDB(dst, b, h) do { _Pragma("unroll") for (int n = 0; n < 2; ++n) _Pragma("unroll") for (int k = 0; k < 2; ++k) dst[n][k] = *(const LAS bf16x8*)(lds + PG8_SB(b, h) + boff + n * 2048 + k * 1024); } while (0)
#define PG8_MMA(ai, bj, At, Bt) do { __builtin_amdgcn_s_setprio(1); _Pragma("unroll") for (int m = 0; m < 4; ++m) _Pragma("unroll") for (int n = 0; n < 2; ++n) _Pragma("unroll") for (int k = 0; k < 2; ++k) \
        acc[ai][bj][m][n] = __builtin_amdgcn_mfma_f32_16x16x32_bf16(Bt[n][k], At[m][k], acc[ai][bj][m][n], 0, 0, 0); __builtin_amdgcn_s_setprio(0); } while (0)
#define PG8_WAIT_V(n) asm volatile("s_waitcnt vmcnt(" #n ")" ::: "memory")
#define PG8_WAIT_L(n) asm volatile("s_waitcnt lgkmcnt(" #n ")" ::: "memory")
#define PG8_BAR __builtin_amdgcn_s_barrier()
#define PG8_SCHED __builtin_amdgcn_sched_barrier(0)
    Unit cur, nxt; int ui = 0;
    if (!S.next(0, cur)) return;
    f32x4 acc[2][2][4][2];
#pragma unroll
    for (int a = 0; a < 2; ++a)
#pragma unroll
        for (int b = 0; b < 2; ++b)
#pragma unroll
            for (int m = 0; m < 4; ++m)
#pragma unroll
                for (int n = 0; n < 2; ++n) acc[a][b][m][n] = (f32x4){0.f, 0.f, 0.f, 0.f};
    bf16x8 At[4][2], B0[2][2], B1[2][2];
    unsigned cO[2][2], nO[2][2];
    S.offs(cur, Rr, Cc, cO);
    const char* cA = cur.A0; const char* cB = cur.B0;
    PG8_STAGE(PG8_SB(0, 0), cB, voffB); PG8_STAGE(PG8_SB(0, 1), cB + hstep, voffB); PG8_STAGE(PG8_SA(0, 0), cA, cO[0]); PG8_STAGE(PG8_SA(0, 1), cA, cO[1]);
    if (wr == 1) PG8_BAR;
    PG8_WAIT_V(2); PG8_BAR;
    PG8_STAGE(PG8_SB(1, 0), cB + kstep, voffB); PG8_STAGE(PG8_SA(1, 0), cA + kstep, cO[0]); PG8_STAGE(PG8_SB(1, 1), cB + hstep + kstep, voffB);
    PG8_WAIT_V(6); PG8_BAR;
    for (;;) {
        const bool has_next = S.next(ui + 1, nxt);
        const char* nA = has_next ? nxt.A0 : cA; const char* nB = has_next ? nxt.B0 : cB;
        if (has_next) { S.offs(nxt, Rr, Cc, nO);
#pragma unroll
            for (int h = 0; h < 2; ++h)
#pragma unroll
                for (int i = 0; i < 2; ++i) asm volatile("" : "+v"(nO[h][i]));
        } else {
#pragma unroll
            for (int h = 0; h < 2; ++h)
#pragma unroll
                for (int i = 0; i < 2; ++i) nO[h][i] = cO[h][i]; }
        for (int t = 0; t < nt; t += 2) {
            const bool last = (t == nt - 2);
            const char* a1 = cA + (size_t)(t + 1) * kstep;
            const char* a2 = last ? nA : cA + (size_t)(t + 2) * kstep; const char* b2 = last ? nB : cB + (size_t)(t + 2) * kstep;
            const char* a3 = a2 + kstep; const char* b3 = b2 + kstep;
            unsigned o2[2][2];
#pragma unroll
            for (int h = 0; h < 2; ++h)
#pragma unroll
                for (int i = 0; i < 2; ++i) o2[h][i] = last ? nO[h][i] : cO[h][i];
            PG8_LDB(B0, 0, 0); PG8_LDB(B1, 0, 1); PG8_SCHED; PG8_LDA(At, 0, 0); PG8_STAGE(PG8_SA(1, 1), a1, cO[1]);
            PG8_WAIT_V(8); PG8_WAIT_L(0); PG8_BAR; PG8_MMA(0, 0, At, B0); PG8_MMA(0, 1, At, B1); PG8_BAR; PG8_SCHED;
            PG8_LDA(At, 0, 1); PG8_STAGE(PG8_SB(0, 0), b2, voffB); PG8_STAGE(PG8_SB(0, 1), b2 + hstep, voffB); PG8_STAGE(PG8_SA(0, 0), a2, o2[0]);
            PG8_WAIT_V(8); PG8_WAIT_L(0); PG8_BAR; PG8_MMA(1, 0, At, B0); PG8_MMA(1, 1, At, B1); PG8_BAR; PG8_SCHED;
            PG8_LDB(B0, 1, 0); PG8_LDB(B1, 1, 1); PG8_SCHED; PG8_LDA(At, 1, 0); PG8_STAGE(PG8_SA(0, 1), a2, o2[1]);
            PG8_WAIT_V(8); PG8_WAIT_L(0); PG8_BAR; PG8_MMA(0, 0, At, B0); PG8_MMA(0, 1, At, B1); PG8_BAR; PG8_SCHED;
            PG8_LDA(At, 1, 1); PG8_STAGE(PG8_SB(1, 0), b3, voffB); PG8_STAGE(PG8_SB(1, 1), b3 + hstep, voffB); PG8_STAGE(PG8_SA(1, 0), a3, o2[0]);
            PG8_WAIT_V(8); PG8_WAIT_L(0); PG8_BAR; PG8_MMA(1, 0, At, B0); PG8_MMA(1, 1, At, B1); PG8_BAR; PG8_SCHED;
        }
        if (wr == 0) PG8_BAR;
        E(acc, cur, wr, wc, fr, fq);
        if (!has_next) break;
#pragma unroll
        for (int a = 0; a < 2; ++a)
#pragma unroll
            for (int b = 0; b < 2; ++b)
#pragma unroll
                for (int m = 0; m < 4; ++m)
#pragma unroll
                    for (int n = 0; n < 2; ++n) acc[a][b][m][n] = (f32x4){0.f, 0.f, 0.f, 0.f};
        cur = nxt; cA = nA; cB = nB; ++ui;
#pragma unroll
        for (int h = 0; h < 2; ++h)
#pragma unroll
            for (int i = 0; i < 2; ++i) cO[h][i] = nO[h][i];
        if (wr == 1) PG8_BAR;
    }
    PG8_WAIT_V(0);
    PG8_BAR;
#undef PG8_SA
#undef PG8_SB
#undef PG8_STAGE
#undef PG8_LDA
#undef PG8_LDB
#undef PG8_MMA
#undef PG8_WAIT_V
#undef PG8_WAIT_L
#undef PG8_BAR
#undef PG8_SCHED
}

struct EpiBf16 {
    static constexpr bool PERM = true;
    bf16* O; int ldc; const float* bias; int bias_ld;
    __device__ __forceinline__ void operator()(const f32x4 (&acc)[2][2][4][2], const Unit& u, int wr, int wc, int fr, int fq) const {
        const int row0 = u.orow + wr * 64 + fr, col0 = u.pn * BM + wc * 32 + 8 * fq;
        f32x4 bv[2][2];
#pragma unroll
        for (int bj = 0; bj < 2; ++bj)
#pragma unroll
            for (int n = 0; n < 2; ++n) bv[bj][n] = bias ? *(const f32x4*)(bias + (size_t)u.e * bias_ld + col0 + bj * HALF + 4 * n) : (f32x4){0.f, 0.f, 0.f, 0.f};
#pragma unroll
        for (int ai = 0; ai < 2; ++ai)
#pragma unroll
            for (int m = 0; m < 4; ++m) { bf16* rowp = O + (size_t)(row0 + ai * HALF + m * 16) * ldc + col0;
#pragma unroll
                for (int bj = 0; bj < 2; ++bj) { const f32x4 v0 = acc[ai][bj][m][0] + bv[bj][0], v1 = acc[ai][bj][m][1] + bv[bj][1];
                    u32x4 w; w.x = cvt_pk_bf16(v0[0], v0[1]); w.y = cvt_pk_bf16(v0[2], v0[3]); w.z = cvt_pk_bf16(v1[0], v1[1]); w.w = cvt_pk_bf16(v1[2], v1[3]);
                    *(u32x4*)(rowp + bj * HALF) = w; } }
    }
};
template <bool FIRST> struct EpiMerge {
    static constexpr bool PERM = true;
    const bf16* Gt; bf16* O;
    __device__ __forceinline__ void operator()(const f32x4 (&acc)[2][2][4][2], const Unit& u, int wr, int wc, int fr, int fq) const {
        const int row0 = u.orow + wr * 64 + fr, col0 = u.pn * BM + wc * 32 + 8 * fq;
#pragma unroll
        for (int ai = 0; ai < 2; ++ai)
#pragma unroll
            for (int m = 0; m < 4; ++m) { const size_t r = (size_t)(row0 + ai * HALF + m * 16);
#pragma unroll
                for (int bj = 0; bj < 2; ++bj) { const u32x4 gw = *(const u32x4*)(Gt + r * NPJ + col0 + bj * HALF);
                    f32x4 v0 = acc[ai][bj][m][0], v1 = acc[ai][bj][m][1];
                    v0[0] *= sigmoidf_(bflo(gw.x)); v0[1] *= sigmoidf_(bfhi(gw.x)); v0[2] *= sigmoidf_(bflo(gw.y)); v0[3] *= sigmoidf_(bfhi(gw.y));
                    v1[0] *= sigmoidf_(bflo(gw.z)); v1[1] *= sigmoidf_(bfhi(gw.z)); v1[2] *= sigmoidf_(bflo(gw.w)); v1[3] *= sigmoidf_(bfhi(gw.w));
                    bf16* op = O + r * DM + col0 + bj * HALF;
                    if (!FIRST) { const u32x4 pw = *(const u32x4*)op;
                        v0[0] += bflo(pw.x); v0[1] += bfhi(pw.x); v0[2] += bflo(pw.y); v0[3] += bfhi(pw.y); v1[0] += bflo(pw.z); v1[1] += bfhi(pw.z); v1[2] += bflo(pw.w); v1[3] += bfhi(pw.w); }
                    u32x4 w; w.x = cvt_pk_bf16(v0[0], v0[1]); w.y = cvt_pk_bf16(v0[2], v0[3]); w.z = cvt_pk_bf16(v1[0], v1[1]); w.w = cvt_pk_bf16(v1[2], v1[3]);
                    *(u32x4*)op = w; } }
    }
};
struct EpiOutRes {
    static constexpr bool PERM = false;
    const float* X; float* O;
    __device__ __forceinline__ void operator()(const f32x4 (&acc)[2][2][4][2], const Unit& u, int wr, int wc, int fr, int fq) const {
        const int row0 = u.orow + wr * 64 + fr, col0 = u.pn * BM + wc * 32 + 4 * fq;
#pragma unroll
        for (int ai = 0; ai < 2; ++ai)
#pragma unroll
            for (int m = 0; m < 4; ++m) { const size_t off = (size_t)(row0 + ai * HALF + m * 16) * DM + col0;
#pragma unroll
                for (int bj = 0; bj < 2; ++bj)
#pragma unroll
                    for (int n = 0; n < 2; ++n) { const f32x4 xv = *(const f32x4*)(X + off + bj * HALF + n * 16); *(f32x4*)(O + off + bj * HALF + n * 16) = xv + acc[ai][bj][m][n]; } }
    }
};
struct EpiSwiGLU {
    static constexpr bool PERM = true;
    const float* bgu; bf16* O;
    __device__ __forceinline__ void operator()(const f32x4 (&acc)[2][2][4][2], const Unit& u, int wr, int wc, int fr, int fq) const {
        const int row0 = u.orow + wr * 64 + fr, col0 = u.pn * HALF + wc * 32 + 8 * fq;
        const float* bg = bgu + (size_t)u.e * 2 * DFF + col0;
        f32x4 bgt[2], bln[2];
#pragma unroll
        for (int n = 0; n < 2; ++n) { bgt[n] = *(const f32x4*)(bg + 4 * n); bln[n] = *(const f32x4*)(bg + DFF + 4 * n); }
#pragma unroll
        for (int ai = 0; ai < 2; ++ai)
#pragma unroll
            for (int m = 0; m < 4; ++m) { float o[8];
#pragma unroll
                for (int n = 0; n < 2; ++n) { const f32x4 gt = acc[ai][0][m][n] + bgt[n], ln = acc[ai][1][m][n] + bln[n];
#pragma unroll
                    for (int j = 0; j < 4; ++j) { const float gg = fminf(gt[j], 7.0f), ll = fminf(fmaxf(ln[j], -7.0f), 7.0f); o[4 * n + j] = (ll + 1.0f) * gg * sigmoidf_(1.702f * gg); } }
                u32x4 w; w.x = cvt_pk_bf16(o[0], o[1]); w.y = cvt_pk_bf16(o[2], o[3]); w.z = cvt_pk_bf16(o[4], o[5]); w.w = cvt_pk_bf16(o[6], o[7]);
                *(u32x4*)(O + (size_t)(row0 + ai * HALF + m * 16) * DFF + col0) = w; }
    }
};
}
__device__ __forceinline__ int srccol_in(int n) {
    if (n < 1024) return n;
    if (n < 1280) return 1536 + (n - 1024);
    if (n < 1792) return 1832 + (n - 1280);
    if (n < 2304) return 2344 + (n - 1792);
    if (n < 2816) return 2856 + (n - 2304);
    if (n < 3328) return 3368 + (n - 2816);
    if (n < 4352) return 3880 + (n - 3328);
    if (n < 5376) return 4904 + (n - 4352);
    if (n < 5384) return 1792 + (n - 5376);
    if (n < 5416) return 1800 + (n - 5384);
    return -1;
}
template <int MAP> __device__ __forceinline__ int srccol(int n) {
    if (MAP == 1) return srccol_in(n);
    if (MAP == 2) return 1024 + n;
    if (MAP == 3) { const int pn = n >> 8, j = n & 255; return j < 128 ? pn * 128 + j : 1024 + pn * 128 + (j - 128); }
    return n;
}
template <int MAP> __device__ __forceinline__ void tr_item(const float* W, int ldw, int Kd, bf16* WT, int k0, int n0, LAS float* scr, int lane) {
    const int nq = lane & 7, sc = srccol<MAP>(n0 + 4 * nq);
#pragma unroll
    for (int i = 0; i < 8; ++i) { const int kk = (lane >> 3) + 8 * i;
        f32x4 v = (f32x4){0.f, 0.f, 0.f, 0.f}; if (sc >= 0) v = *(const f32x4*)(W + (size_t)(k0 + kk) * ldw + sc);
        LAS float* d = scr + kk * 33 + 4 * nq; d[0] = v[0]; d[1] = v[1]; d[2] = v[2]; d[3] = v[3]; }
    LDS_WAIT(); asm volatile("" ::: "memory");
    const int c = lane & 7;
#pragma unroll
    for (int j = 0; j < 4; ++j) { const int n = (lane >> 3) + 8 * j; const LAS float* s = scr + (8 * c) * 33 + n;
        u32x4 o; o.x = cvt_pk_bf16(s[0 * 33], s[1 * 33]); o.y = cvt_pk_bf16(s[2 * 33], s[3 * 33]); o.z = cvt_pk_bf16(s[4 * 33], s[5 * 33]); o.w = cvt_pk_bf16(s[6 * 33], s[7 * 33]);
        *(u32x4*)(WT + (size_t)(n0 + n) * Kd + k0 + 8 * c) = o; }
    LDS_WAIT(); asm volatile("" ::: "memory");
}
template <int MAP> __device__ __forceinline__ void tr_matrix(const float* W, int ldw, int Kd, int Nd, bf16* WT, LAS float* scr, int lane, int gw, int NGW) {
    const int nkb = Kd / 64, nnb = Nd / 32, n = nkb * nnb;
    for (int it = gw; it < n; it += NGW) { const int kb = it / nnb, nb = it % nnb; tr_item<MAP>(W, ldw, Kd, WT, 64 * kb, 32 * nb, scr, lane); }
}
__device__ __forceinline__ void rms_row_to_bf16(const float* xrow, const float* gain, bf16* orow, int lane) {
    const f32x4* xr = (const f32x4*)xrow + lane; const f32x4* gr = (const f32x4*)gain + lane;
    f32x4 v[4]; float s = 0.f;
#pragma unroll
    for (int j = 0; j < 4; ++j) { v[j] = xr[64 * j]; s += (v[j][0] * v[j][0] + v[j][1] * v[j][1]) + (v[j][2] * v[j][2] + v[j][3] * v[j][3]); }
    const float rstd = rsqrtf(wave_sum(s) * (1.f / DM) + EPS);
    u32x2* o8 = (u32x2*)orow + lane;
#pragma unroll
    for (int j = 0; j < 4; ++j) { const f32x4 g = gr[64 * j]; u32x2 w; w.x = cvt_pk_bf16(v[j][0] * rstd * g[0], v[j][1] * rstd * g[1]); w.y = cvt_pk_bf16(v[j][2] * rstd * g[2], v[j][3] * rstd * g[3]); o8[64 * j] = w; }
}

struct P0Args { const float *x, *w_in, *w_up_a, *w_up_b, *w_out, *norm_mix, *w_gu, *w_down; unsigned char* ws; };
__device__ __forceinline__ void p0_prologue(const P0Args& a, LAS unsigned char* lds, int wave, int lane, int vcu, int G) {
    LAS float* scr = (LAS float*)(lds + wave * 16384);
    const int gw = vcu * 8 + wave, NGW = G * 8;
    unsigned char* ws = a.ws;
    tr_matrix<1>(a.w_in, 5928, DM, NPJ, (bf16*)(ws + WS_WIN), scr, lane, gw, NGW);
    tr_matrix<2>(a.w_in, 5928, DM, 512, (bf16*)(ws + WS_WV), scr, lane, gw, NGW);
    tr_matrix<0>(a.w_up_a, DM, 512, DM, (bf16*)(ws + WS_WUA), scr, lane, gw, NGW);
    tr_matrix<0>(a.w_up_b, DM, 512, DM, (bf16*)(ws + WS_WUB), scr, lane, gw, NGW);
    tr_matrix<0>(a.w_out, DM, DM, DM, (bf16*)(ws + WS_WO), scr, lane, gw, NGW);
    for (int m = gw; m < T; m += NGW) rms_row_to_bf16(a.x + (size_t)m * DM, a.norm_mix, (bf16*)(ws + WS_XN) + (size_t)m * DM, lane);
    for (int e = 0; e < NEXP; ++e) {
        tr_matrix<3>(a.w_gu + (size_t)e * DM * 2 * DFF, 2 * DFF, DM, 2 * DFF, (bf16*)(ws + WS_WGU) + (size_t)e * 2 * DFF * DM, scr, lane, (gw + 61 * e) % NGW, NGW);
        tr_matrix<0>(a.w_down + (size_t)e * DFF * DM, DM, DFF, DM, (bf16*)(ws + WS_WDN) + (size_t)e * DM * DFF, scr, lane, (gw + 37 * e) % NGW, NGW);
    }
}

struct P6Args { const float* x1; const float* norm_ffn; const float* w_router; const float* b_router; bf16* h2; unsigned* cnt; int* tokl; u32x2* toki; };
__device__ __forceinline__ void p6_router(const P6Args& a, LAS unsigned char* lds, int tid, int wave, int lane, int vcu, int G) {
    LAS float* xs = (LAS float*)lds;
    LAS float* part = (LAS float*)(lds + 65536);
    LAS unsigned* lcnt = (LAS unsigned*)(lds + 98304);
    LAS unsigned* lbase = lcnt + 32;
    LAS unsigned* lsel = lcnt + 64;
    LAS float* lgate = (LAS float*)(lcnt + 64 + 512);
    const int rows_per = 128;
    for (int base = vcu * rows_per; base < T; base += G * rows_per) {
        if (tid < 32) lcnt[tid] = 0u;
        __syncthreads();
        for (int ch = 0; ch < 8; ++ch) {
#pragma unroll 1
            for (int q = 0; q < 2; ++q) { const int r = 2 * wave + q, t = base + ch * 16 + r;
                const f32x4* xr = (const f32x4*)(a.x1 + (size_t)t * DM) + lane; const f32x4* gr = (const f32x4*)a.norm_ffn + lane;
                f32x4 v[4]; float s = 0.f;
#pragma unroll
                for (int j = 0; j < 4; ++j) { v[j] = xr[64 * j]; s += (v[j][0] * v[j][0] + v[j][1] * v[j][1]) + (v[j][2] * v[j][2] + v[j][3] * v[j][3]); }
                const float rstd = rsqrtf(wave_sum(s) * (1.f / DM) + EPS);
                u32x2* o8 = (u32x2*)(a.h2 + (size_t)t * DM) + lane;
#pragma unroll
                for (int j = 0; j < 4; ++j) { const f32x4 g = gr[64 * j]; v[j] = v[j] * rstd * g; u32x2 w; w.x = cvt_pk_bf16(v[j][0], v[j][1]); w.y = cvt_pk_bf16(v[j][2], v[j][3]); o8[64 * j] = w;
                    *(LAS f32x4*)(xs + r * 1024 + 4 * lane + 256 * j) = v[j]; }
            }
            __syncthreads();
            { const int e = lane & 31, kh = lane >> 5, k0 = 128 * wave + 64 * kh;
              float acc[16];
#pragma unroll
              for (int r = 0; r < 16; ++r) acc[r] = 0.f;
#pragma unroll 2
              for (int kk = 0; kk < 64; kk += 4) { const float* wp = a.w_router + (size_t)(k0 + kk) * NEXP + e;
                  const float w0 = wp[0], w1 = wp[NEXP], w2 = wp[2 * NEXP], w3 = wp[3 * NEXP];
#pragma unroll
                  for (int r = 0; r < 16; ++r) { const f32x4 xv = *(const LAS f32x4*)(xs + r * 1024 + k0 + kk); acc[r] += (xv[0] * w0 + xv[1] * w1) + (xv[2] * w2 + xv[3] * w3); } }
#pragma unroll
              for (int r = 0; r < 16; ++r) part[((wave * 2 + kh) * 16 + r) * 32 + e] = acc[r];
            }
            __syncthreads();
            { const int r = tid >> 5, e = tid & 31; float lg = a.b_router[e];
#pragma unroll
              for (int p = 0; p < 16; ++p) lg += part[(p * 16 + r) * 32 + e];
              float tv[4]; int te[4]; float cur = lg;
#pragma unroll
              for (int k = 0; k < 4; ++k) { float bv = cur; int be = e;
#pragma unroll
                  for (int o = 1; o < 32; o <<= 1) { const float ov = __shfl_xor(bv, o); const int oe = __shfl_xor(be, o); if (ov > bv || (ov == bv && oe < be)) { bv = ov; be = oe; } }
                  tv[k] = bv; te[k] = be; if (e == be) cur = -INFINITY; }
              const float e1 = __expf(tv[1] - tv[0]), e2 = __expf(tv[2] - tv[0]), e3 = __expf(tv[3] - tv[0]); const float inv = 1.f / (1.f + e1 + e2 + e3);
              if (e < 4) { const int ee = e == 0 ? te[0] : e == 1 ? te[1] : e == 2 ? te[2] : te[3]; const float gg = (e == 0 ? 1.f : e == 1 ? e1 : e == 2 ? e2 : e3) * inv;
                  const unsigned lr = __hip_atomic_fetch_add(&lcnt[ee], 1u, __ATOMIC_RELAXED, __HIP_MEMORY_SCOPE_WORKGROUP); const int ri = ch * 16 + r; lsel[ri * 4 + e] = (unsigned)ee | (lr << 8); lgate[ri * 4 + e] = gg; }
            }
            __syncthreads();
        }
        if (tid < 32) lbase[tid] = __hip_atomic_fetch_add(a.cnt + 16 * tid, lcnt[tid], __ATOMIC_RELAXED, __HIP_MEMORY_SCOPE_AGENT);
        __syncthreads();
        for (int i = tid; i < rows_per * 4; i += 512) { const unsigned s = lsel[i]; const int e = s & 255; const unsigned pos = lbase[e] + (s >> 8); const int t = base + (i >> 2);
            a.toki[(size_t)t * 4 + (i & 3)] = (u32x2){(unsigned)e | (pos << 8), __float_as_uint(lgate[i])}; a.tokl[(size_t)e * T + pos] = t; }
        __syncthreads();
    }
}

__device__ __forceinline__ void p9_final(float* out, const bf16* yexp, const u32x2* toki, const unsigned* cnt, const float* norm_final, LAS unsigned char* lds, int tid, int wave, int lane, int vcu, int G) {
    LAS int* pst = (LAS int*)lds;
    if (tid == 0) { int acc = 0; for (int e = 0; e < NEXP; ++e) { pst[e] = acc; acc += ((int)cnt[16 * e] + 255) / 256 * 256; } }
    __syncthreads();
    const int gw = vcu * 8 + wave, NGW = G * 8;
    for (int t = gw; t < T; t += NGW) {
        f32x4* xr = (f32x4*)(out + (size_t)t * DM) + lane; const f32x4* gr = (const f32x4*)norm_final + lane;
        f32x4 v[4];
#pragma unroll
        for (int j = 0; j < 4; ++j) v[j] = xr[64 * j];
#pragma unroll
        for (int k = 0; k < 4; ++k) { const u32x2 ti = toki[(size_t)t * 4 + k]; const int e = ti.x & 255; const int pos = ti.x >> 8; const float g = __uint_as_float(ti.y);
            const u32x2* yr = (const u32x2*)(yexp + (size_t)(pst[e] + pos) * DM) + lane;
#pragma unroll
            for (int j = 0; j < 4; ++j) { const u32x2 w = yr[64 * j]; v[j][0] += g * bflo(w.x); v[j][1] += g * bfhi(w.x); v[j][2] += g * bflo(w.y); v[j][3] += g * bfhi(w.y); } }
        float s = 0.f;
#pragma unroll
        for (int j = 0; j < 4; ++j) s += (v[j][0] * v[j][0] + v[j][1] * v[j][1]) + (v[j][2] * v[j][2] + v[j][3] * v[j][3]);
        const float rstd = rsqrtf(wave_sum(s) * (1.f / DM) + EPS);
#pragma unroll
        for (int j = 0; j < 4; ++j) { const f32x4 g = gr[64 * j]; xr[64 * j] = v[j] * rstd * g; }
    }
}
#define HAVE_MIX 1
struct MixArgs { const bf16* PROJ; const bf16* VT; unsigned short* MASKQ; bf16* YA; bf16* YB; float* HU; float* HD; const float* hgrn_norm; const float* lb_logits; const float* rel_bias; };
__device__ const unsigned char T5BUCKET[129] = {0, 1, 2, 3, 4, 5, 6, 7, 8, 9, 10, 11, 12, 13, 14, 15, 16, 16, 16, 17, 17, 18, 18, 18, 19, 19, 19, 20, 20, 20, 20, 21, 21, 21, 21, 22, 22, 22, 22, 22, 23, 23, 23, 23, 23, 23, 24, 24, 24, 24, 24, 24, 25, 25, 25, 25, 25, 25, 25, 26, 26, 26, 26, 26, 26, 26, 26, 27, 27, 27, 27, 27, 27, 27, 27, 27, 27, 28, 28, 28, 28, 28, 28, 28, 28, 28, 28, 29, 29, 29, 29, 29, 29, 29, 29, 29, 29, 29, 29, 30, 30, 30, 30, 30, 30, 30, 30, 30, 30, 30, 30, 30, 30, 31, 31, 31, 31, 31, 31, 31, 31, 31, 31, 31, 31, 31, 31, 31, 31};
constexpr float LOG2E = 1.4426950408889634f;
__device__ __forceinline__ bf16x8 pack8(float a0, float a1, float a2, float a3, float a4, float a5, float a6, float a7) {
    u32x4 w; w.x = cvt_pk_bf16(a0, a1); w.y = cvt_pk_bf16(a2, a3); w.z = cvt_pk_bf16(a4, a5); w.w = cvt_pk_bf16(a6, a7); return __builtin_bit_cast(bf16x8, w);
}
__device__ __forceinline__ bf16x8 lo4(u32x2 v) { u32x4 w; w.x = v.x; w.y = v.y; w.z = 0u; w.w = 0u; return __builtin_bit_cast(bf16x8, w); }

__device__ __forceinline__ void pidx_unit(const MixArgs& m, LAS unsigned char* lds, int tid, int wave, int lane, int b, int qt) {
    LAS unsigned* hist = (LAS unsigned*)lds;
    LAS unsigned* s_pfx = (LAS unsigned*)(lds + 16512);
    LAS unsigned* s_k2 = (LAS unsigned*)(lds + 16640);
    LAS unsigned* s_krem = (LAS unsigned*)(lds + 16768);
    LAS unsigned* kbq = (LAS unsigned*)(lds + 16896);
    const int c = lane & 15, g = lane >> 4;
    const size_t rowq = (size_t)b * SEQ + (size_t)qt * 16;
    const bf16* PROJ = m.PROJ;
    for (int i = tid; i < 16 * 257; i += 512) hist[i] = 0u;
    for (int i = tid; i < 16 * 128; i += 512) kbq[i] = 0u;
    if (tid < 16) { s_pfx[tid] = 0u; s_k2[tid] = 0u; const int nv = qt * 16 + tid + 1; s_krem[tid] = (unsigned)(nv < 256 ? nv : 256); }
    const float WS = 0.35355339059327373f * 0.17677669529663687f * 0.5f;
    bf16x8 qf[8];
#pragma unroll
    for (int h = 0; h < 8; ++h) qf[h] = *(const bf16x8*)(PROJ + (rowq + c) * NPJ + C_IQ + h * 32 + 8 * g);
    bf16x8 ql; float wq[8];
    { const u32x4 wr = *(const u32x4*)(PROJ + (rowq + c) * NPJ + C_IW);
      wq[0] = bflo(wr.x) * WS; wq[1] = bfhi(wr.x) * WS; wq[2] = bflo(wr.y) * WS; wq[3] = bfhi(wr.y) * WS; wq[4] = bflo(wr.z) * WS; wq[5] = bfhi(wr.z) * WS; wq[6] = bflo(wr.w) * WS; wq[7] = bfhi(wr.w) * WS;
      float a[8];
#pragma unroll
      for (int j = 0; j < 8; ++j) { a[j] = 0.f;
#pragma unroll
          for (int h = 0; h < 8; ++h) a[j] += wq[h] * bf2f((unsigned short)qf[h][j]); }
      ql = pack8(a[0], a[1], a[2], a[3], a[4], a[5], a[6], a[7]); }
    const int ngrp = qt / 4 + 1, tq = qt * 16 + c;
    unsigned sc[8][4][4];
#pragma unroll
    for (int slot = 0; slot < 8; ++slot) {
        const int g64 = slot * 8 + wave;
        if (g64 < ngrp) {
#pragma unroll
            for (int j = 0; j < 4; ++j) { const int key0 = (g64 * 4 + j) * 16;
                const bf16x8 kf = *(const bf16x8*)(PROJ + ((size_t)b * SEQ + key0 + c) * NPJ + C_IK + 8 * g);
                f32x4 acc = __builtin_amdgcn_mfma_f32_16x16x32_bf16(kf, ql, (f32x4){0.f, 0.f, 0.f, 0.f}, 0, 0, 0);
#pragma unroll
                for (int h = 0; h < 8; ++h) { const f32x4 d = __builtin_amdgcn_mfma_f32_16x16x32_bf16(kf, qf[h], (f32x4){0.f, 0.f, 0.f, 0.f}, 0, 0, 0);
#pragma unroll
                    for (int i = 0; i < 4; ++i) acc[i] += wq[h] * __builtin_fabsf(d[i]); }
#pragma unroll
                for (int i = 0; i < 4; ++i) { const bool valid = key0 + 4 * g + i <= tq; const unsigned bits = __float_as_uint(acc[i]); const unsigned u = bits ^ ((unsigned)((int)bits >> 31) | 0x80000000u); sc[slot][j][i] = valid ? u : 0u; } }
        } else {
#pragma unroll
            for (int j = 0; j < 4; ++j)
#pragma unroll
                for (int i = 0; i < 4; ++i) sc[slot][j][i] = 0u;
        }
    }
    __syncthreads();
#pragma unroll
    for (int p = 0; p < 6; ++p) {
        const int rb = p & 1, wb = rb ^ 1;
        const unsigned pf = s_pfx[rb * 16 + c], k2p = s_k2[rb * 16 + c];
#pragma unroll
        for (int slot = 0; slot < 8; ++slot) {
            const int g64 = slot * 8 + wave;
            if (g64 < ngrp) {
#pragma unroll
                for (int j = 0; j < 4; ++j)
#pragma unroll
                    for (int i = 0; i < 4; ++i) { const unsigned u = sc[slot][j][i]; const unsigned key2 = 4095u - (unsigned)((g64 * 4 + j) * 16 + 4 * g + i);
                        bool part; unsigned bin;
                        if (p == 0) { part = u != 0u; bin = u >> 24; }
                        else if (p < 4) { const int sh = 24 - 8 * p; part = (u != 0u) && ((u >> (sh + 8)) == (pf >> (sh + 8))); bin = (u >> sh) & 255u; }
                        else if (p == 4) { part = (u != 0u) && (u == pf); bin = key2 >> 4; }
                        else { part = (u != 0u) && (u == pf) && ((key2 >> 4) == (k2p >> 4)); bin = key2 & 15u; }
                        if (part) (void)__hip_atomic_fetch_add(&hist[c * 257 + bin], 1u, __ATOMIC_RELAXED, __HIP_MEMORY_SCOPE_WORKGROUP); }
            }
        }
        __syncthreads();
        { const int qq = tid >> 5, jj = tid & 31; const unsigned krem = s_krem[rb * 16 + qq];
          unsigned h8[8]; unsigned csum = 0u;
#pragma unroll
          for (int k = 0; k < 8; ++k) { h8[k] = hist[qq * 257 + 255 - 8 * jj - k]; csum += h8[k]; }
          unsigned incl = csum;
#pragma unroll
          for (int o = 1; o < 32; o <<= 1) { const unsigned v = __shfl_up(incl, o, 32); if (jj >= o) incl += v; }
          const unsigned excl = incl - csum;
          if (excl < krem && krem <= incl) { unsigned run = excl, bin = 0u, newk = 0u; bool done = false;
#pragma unroll
              for (int k = 0; k < 8; ++k) { if (!done) { if (run + h8[k] >= krem) { bin = (unsigned)(255 - 8 * jj - k); newk = krem - run; done = true; } else run += h8[k]; } }
              const unsigned op = s_pfx[rb * 16 + qq], ok2 = s_k2[rb * 16 + qq];
              if (p < 4) { s_pfx[wb * 16 + qq] = op | (bin << (24 - 8 * (p < 4 ? p : 0))); s_k2[wb * 16 + qq] = 0u; }
              else if (p == 4) { s_pfx[wb * 16 + qq] = op; s_k2[wb * 16 + qq] = bin << 4; }
              else { s_pfx[wb * 16 + qq] = op; s_k2[wb * 16 + qq] = ok2 | bin; }
              s_krem[wb * 16 + qq] = newk; }
#pragma unroll
          for (int k = 0; k < 8; ++k) hist[qq * 257 + 255 - 8 * jj - k] = 0u;
        }
        __syncthreads();
    }
    { const unsigned thr = s_pfx[c], tk2 = s_k2[c];
#pragma unroll
      for (int slot = 0; slot < 8; ++slot) {
          const int g64 = slot * 8 + wave;
          if (g64 < ngrp) {
#pragma unroll
              for (int j = 0; j < 4; ++j)
#pragma unroll
                  for (int i = 0; i < 4; ++i) { const unsigned u = sc[slot][j][i]; const int key = (g64 * 4 + j) * 16 + 4 * g + i; const unsigned key2 = 4095u - (unsigned)key;
                      const bool sel = (u > thr) || (u == thr && u != 0u && key2 >= tk2);
                      if (sel) (void)__hip_atomic_fetch_or(&kbq[c * 128 + (key >> 5)], 1u << (key & 31), __ATOMIC_RELAXED, __HIP_MEMORY_SCOPE_WORKGROUP); }
          }
      }
    }
    __syncthreads();
    for (int idx = tid; idx < 16 * ngrp; idx += 512) { const int qq = idx & 15, gg = idx >> 4;
        *(u32x2*)(m.MASKQ + (rowq + qq) * 256 + 4 * gg) = *(const LAS u32x2*)(kbq + qq * 128 + 2 * gg); }
    __syncthreads();
}

__device__ __forceinline__ void attn_unit(const MixArgs& m, LAS unsigned char* lds, int tid, int wave, int lane, int b, int h, int qb) {
    LAS bf16* Ks = (LAS bf16*)lds;
    LAS bf16* Vs = (LAS bf16*)(lds + 18432);
    LAS float* btab = (LAS float*)(lds + 36864);
    const int r32 = lane & 31, hi = lane >> 5;
    if (tid < 129) btab[tid] = m.rel_bias[(int)T5BUCKET[tid] * 8 + h] * LOG2E;
    const float bfar = m.rel_bias[31 * 8 + h] * LOG2E;
    const float C2 = 0.125f * LOG2E;
    const int q0w = qb * 256 + 32 * wave;
    const size_t rowq = (size_t)b * SEQ + q0w + r32;
    bf16x8 qf[4];
#pragma unroll
    for (int ds = 0; ds < 4; ++ds) qf[ds] = *(const bf16x8*)(m.PROJ + rowq * NPJ + C_AQ + h * 64 + 16 * ds + 8 * hi);
    const int NT = 4 * qb + 4, tw = 4 * qb + (wave >> 1);
    const int srow = tid >> 3, sch = tid & 7;
    const bf16* kptr = m.PROJ + ((size_t)b * SEQ + srow) * NPJ + C_AK + h * 64 + 8 * sch;
    const bf16* vptr = m.VT + (size_t)(h * 64 + srow) * T + (size_t)b * SEQ + 8 * sch;
    u32x4 kr = *(const u32x4*)kptr, vr = *(const u32x4*)vptr;
    *(LAS u32x4*)(Ks + srow * 72 + 8 * sch) = kr; *(LAS u32x4*)(Vs + srow * 72 + 8 * sch) = vr;
    __syncthreads();
    float m_run = -INFINITY, l_run = 0.f; f32x16 o[2];
#pragma unroll
    for (int r = 0; r < 16; ++r) { o[0][r] = 0.f; o[1][r] = 0.f; }
    const unsigned long long* mrow = (const unsigned long long*)(m.MASKQ + rowq * 256);
    for (int t = 0; t < NT; ++t) {
        const int buf = t & 1;
        if (t + 1 < NT) { kr = *(const u32x4*)(kptr + (size_t)(t + 1) * 64 * NPJ); vr = *(const u32x4*)(vptr + (t + 1) * 64); }
        if (t <= tw) {
            const unsigned long long mw = mrow[t] >> (4 * hi);
            const unsigned mlo = (unsigned)mw, mhi = (unsigned)(mw >> 32);
            f32x16 p[2];
#pragma unroll
            for (int hh = 0; hh < 2; ++hh) {
#pragma unroll
                for (int r = 0; r < 16; ++r) p[hh][r] = 0.f;
#pragma unroll
                for (int ds = 0; ds < 4; ++ds) { const bf16x8 kf = *(const LAS bf16x8*)(Ks + buf * 4608 + (32 * hh + r32) * 72 + 16 * ds + 8 * hi);
                    p[hh] = __builtin_amdgcn_mfma_f32_32x32x16_bf16(kf, qf[ds], p[hh], 0, 0, 0); }
            }
            const bool near = (q0w - (64 * t + 63)) < 128;
            float mx = -INFINITY;
#pragma unroll
            for (int hh = 0; hh < 2; ++hh) { const int dbase = q0w + r32 - (64 * t + 32 * hh + 4 * hi); const unsigned mword = hh ? mhi : mlo;
#pragma unroll
                for (int r = 0; r < 16; ++r) { const int cpos = (r & 3) + 8 * (r >> 2);
                    float bias = bfar;
                    if (near) { int dd = dbase - cpos; dd = dd < 0 ? 0 : (dd > 128 ? 128 : dd); bias = btab[dd]; }
                    float s = p[hh][r] * C2 + bias; s = ((mword >> cpos) & 1u) ? s : -INFINITY; p[hh][r] = s; mx = fmaxf(mx, s); } }
            mx = fmaxf(mx, __shfl_xor(mx, 32));
            const float m_new = fmaxf(m_run, mx); const float msafe = (m_new == -INFINITY) ? 0.f : m_new;
            const float alpha = __builtin_amdgcn_exp2f(m_run - msafe); m_run = m_new;
            float rs = 0.f;
#pragma unroll
            for (int hh = 0; hh < 2; ++hh)
#pragma unroll
                for (int r = 0; r < 16; ++r) { const float e = __builtin_amdgcn_exp2f(p[hh][r] - msafe); p[hh][r] = e; rs += e; }
            l_run = l_run * alpha + rs;
#pragma unroll
            for (int r = 0; r < 16; ++r) { o[0][r] *= alpha; o[1][r] *= alpha; }
#pragma unroll
            for (int ks = 0; ks < 4; ++ks) { const int hh = ks >> 1, s2 = ks & 1;
                const bf16x8 pb = pack8(p[hh][8 * s2 + 0], p[hh][8 * s2 + 1], p[hh][8 * s2 + 2], p[hh][8 * s2 + 3], p[hh][8 * s2 + 4], p[hh][8 * s2 + 5], p[hh][8 * s2 + 6], p[hh][8 * s2 + 7]);
#pragma unroll
                for (int dh = 0; dh < 2; ++dh) { const LAS bf16* vp = Vs + buf * 4608 + (32 * dh + r32) * 72 + 32 * hh + 16 * s2 + 4 * hi;
                    const u32x2 v0 = *(const LAS u32x2*)vp, v1 = *(const LAS u32x2*)(vp + 8);
                    u32x4 vw; vw.x = v0.x; vw.y = v0.y; vw.z = v1.x; vw.w = v1.y;
                    o[dh] = __builtin_amdgcn_mfma_f32_32x32x16_bf16(__builtin_bit_cast(bf16x8, vw), pb, o[dh], 0, 0, 0); } }
        }
        if (t + 1 < NT) { *(LAS u32x4*)(Ks + (buf ^ 1) * 4608 + srow * 72 + 8 * sch) = kr; *(LAS u32x4*)(Vs + (buf ^ 1) * 4608 + srow * 72 + 8 * sch) = vr; }
        __syncthreads();
    }
    const float lt = l_run + __shfl_xor(l_run, 32); const float inv = 1.0f / lt;
    bf16* orow = m.YA + rowq * 512 + h * 64;
#pragma unroll
    for (int dh = 0; dh < 2; ++dh)
#pragma unroll
        for (int a = 0; a < 4; ++a) { u32x2 w; w.x = cvt_pk_bf16(o[dh][4 * a] * inv, o[dh][4 * a + 1] * inv); w.y = cvt_pk_bf16(o[dh][4 * a + 2] * inv, o[dh][4 * a + 3] * inv);
            *(u32x2*)(orow + 32 * dh + 8 * a + 4 * hi) = w; }
    __syncthreads();
}

template <bool OUT> __device__ __forceinline__ void hgrn_unit(const MixArgs& m, LAS unsigned char* lds, int tid, int wave, int lane, int b, int h, int c) {
    LAS bf16* QT = (LAS bf16*)lds;
    LAS bf16* KH = (LAS bf16*)(lds + 4352);
    LAS bf16* KT = (LAS bf16*)(lds + 8704);
    LAS bf16* VTL = (LAS bf16*)(lds + 12800);
    LAS float* DEC = (LAS float*)(lds + 16896);
    LAS float* PART = (LAS float*)(lds + 17408);
    LAS float* OBUF = (LAS float*)(lds + 19456);
    const bf16* PROJ = m.PROJ;
    const int d = tid & 127, tq = tid >> 7;
    const int c16 = lane & 15, g = lane >> 4;
    const int bh = b * 4 + h;
    const float lbv = sigmoidf_(m.lb_logits[h * 128 + d] - m.lb_logits[512 + h * 128 + d]);
    float Btot = 0.f;
    f32x4 st[8];
#pragma unroll
    for (int dt = 0; dt < 8; ++dt) st[dt] = (f32x4){0.f, 0.f, 0.f, 0.f};
    if (OUT) {
        const int e = 16 * wave + c16;
        for (int j = 0; j < c; ++j) { const float* U = m.HU + (size_t)(bh * 16 + j) * 16384; const float* Dj = m.HD + (size_t)(bh * 16 + j) * 128;
#pragma unroll
            for (int dt = 0; dt < 8; ++dt) { const f32x4 dv = *(const f32x4*)(Dj + 16 * dt + 4 * g);
#pragma unroll
                for (int i = 0; i < 4; ++i) st[dt][i] = dv[i] * st[dt][i] + U[(size_t)(16 * dt + 4 * g + i) * 128 + e]; } }
    }
    for (int s16 = 0; s16 < 16; ++s16) {
        const size_t row0 = (size_t)b * SEQ + (size_t)c * 256 + s16 * 16;
        float gl[4], kk[4], qs[4], cum[4]; unsigned short vraw[4];
#pragma unroll
        for (int k = 0; k < 4; ++k) { const bf16* pr = PROJ + (row0 + 4 * tq + k) * NPJ + h * 128 + d;
            const float fr = bf2f(pr[C_BF]), qr = bf2f(pr[C_BQ]); vraw[k] = pr[C_BI];
            const float f = lbv + (1.f - lbv) * sigmoidf_(fr); gl[k] = __logf(f); kk[k] = 1.f - f; qs[k] = qr * sigmoidf_(qr) * 0.08838834764831845f; }
        cum[0] = gl[0]; cum[1] = cum[0] + gl[1]; cum[2] = cum[1] + gl[2]; cum[3] = cum[2] + gl[3];
        PART[tq * 128 + d] = cum[3];
        { u32x2 w; w.x = (unsigned)vraw[0] | ((unsigned)vraw[1] << 16); w.y = (unsigned)vraw[2] | ((unsigned)vraw[3] << 16); *(LAS u32x2*)(VTL + d * 16 + 4 * tq) = w; }
        __syncthreads();
        float off = 0.f, tot = 0.f;
#pragma unroll
        for (int q = 0; q < 4; ++q) { const float pv = PART[q * 128 + d]; tot += pv; if (q < tq) off += pv; }
        float kt4[4];
#pragma unroll
        for (int k = 0; k < 4; ++k) { const float Bt = off + cum[k]; const int tt = 4 * tq + k;
            QT[tt * 136 + d] = (bf16)(cvt_pk_bf16(qs[k] * __expf(Bt), 0.f) & 0xffffu);
            KH[tt * 136 + d] = (bf16)(cvt_pk_bf16(kk[k] * __expf(-Bt), 0.f) & 0xffffu);
            kt4[k] = kk[k] * __expf(tot - Bt); }
        { u32x2 w; w.x = cvt_pk_bf16(kt4[0], kt4[1]); w.y = cvt_pk_bf16(kt4[2], kt4[3]); *(LAS u32x2*)(KT + d * 16 + 4 * tq) = w; }
        if (tq == 0) { DEC[d] = __expf(tot); Btot += tot; }
        __syncthreads();
        const bf16x8 bv = lo4(*(const LAS u32x2*)(VTL + (16 * wave + c16) * 16 + 4 * g));
        if (OUT) {
            f32x4 acc = (f32x4){0.f, 0.f, 0.f, 0.f}, aT = (f32x4){0.f, 0.f, 0.f, 0.f};
#pragma unroll
            for (int ks = 0; ks < 4; ++ks) {
                const u32x2 a0 = *(const LAS u32x2*)(QT + c16 * 136 + 32 * ks + 4 * g), a1 = *(const LAS u32x2*)(QT + c16 * 136 + 32 * ks + 16 + 4 * g);
                u32x4 aw; aw.x = a0.x; aw.y = a0.y; aw.z = a1.x; aw.w = a1.y;
                const bf16x8 sb = pack8(st[2 * ks][0], st[2 * ks][1], st[2 * ks][2], st[2 * ks][3], st[2 * ks + 1][0], st[2 * ks + 1][1], st[2 * ks + 1][2], st[2 * ks + 1][3]);
                acc = __builtin_amdgcn_mfma_f32_16x16x32_bf16(__builtin_bit_cast(bf16x8, aw), sb, acc, 0, 0, 0);
                const bf16x8 kh = *(const LAS bf16x8*)(KH + c16 * 136 + 32 * ks + 8 * g), qn = *(const LAS bf16x8*)(QT + c16 * 136 + 32 * ks + 8 * g);
                aT = __builtin_amdgcn_mfma_f32_16x16x32_bf16(kh, qn, aT, 0, 0, 0);
            }
#pragma unroll
            for (int i = 0; i < 4; ++i) if (4 * g + i > c16) aT[i] = 0.f;
            const bf16x8 aa = pack8(aT[0], aT[1], aT[2], aT[3], 0.f, 0.f, 0.f, 0.f);
            acc = __builtin_amdgcn_mfma_f32_16x16x32_bf16(aa, bv, acc, 0, 0, 0);
#pragma unroll
            for (int i = 0; i < 4; ++i) OBUF[(4 * g + i) * 132 + 16 * wave + c16] = acc[i];
        }
#pragma unroll
        for (int dt = 0; dt < 8; ++dt) { const bf16x8 ka = lo4(*(const LAS u32x2*)(KT + (16 * dt + c16) * 16 + 4 * g)); const f32x4 dv = *(const LAS f32x4*)(DEC + 16 * dt + 4 * g);
            st[dt] = __builtin_amdgcn_mfma_f32_16x16x32_bf16(ka, bv, st[dt] * dv, 0, 0, 0); }
        __syncthreads();
        if (OUT) {
#pragma unroll 1
            for (int q = 0; q < 2; ++q) { const int t = 2 * wave + q; const float o0 = OBUF[t * 132 + lane], o1 = OBUF[t * 132 + 64 + lane];
                const float rstd = rsqrtf(wave_sum(o0 * o0 + o1 * o1) * (1.f / 128.f) + EPS);
                const bf16* pg = PROJ + (row0 + t) * NPJ + C_BG + h * 128; const float g0 = bf2f(pg[lane]), g1 = bf2f(pg[64 + lane]);
                const float y0 = o0 * rstd * m.hgrn_norm[h * 128 + lane] * g0 * sigmoidf_(g0), y1 = o1 * rstd * m.hgrn_norm[h * 128 + 64 + lane] * g1 * sigmoidf_(g1);
                bf16* yo = m.YB + (row0 + t) * 512 + h * 128;
                yo[lane] = (bf16)(cvt_pk_bf16(y0, 0.f) & 0xffffu); yo[64 + lane] = (bf16)(cvt_pk_bf16(y1, 0.f) & 0xffffu); }
        }
    }
    if (!OUT) {
        const int e = 16 * wave + c16; float* U = m.HU + (size_t)(bh * 16 + c) * 16384;
#pragma unroll
        for (int dt = 0; dt < 8; ++dt)
#pragma unroll
            for (int i = 0; i < 4; ++i) U[(size_t)(16 * dt + 4 * g + i) * 128 + e] = st[dt][i];
        if (tq == 0) m.HD[(size_t)(bh * 16 + c) * 128 + d] = __expf(Btot);
    }
    __syncthreads();
}

__device__ __forceinline__ MixArgs make_mix(const Args& args) {
    unsigned char* ws = args.ws;
    return MixArgs{(const bf16*)(ws + WS_PROJ), (const bf16*)(ws + WS_VT), (unsigned short*)(ws + WS_MASK), (bf16*)(ws + WS_YA), (bf16*)(ws + WS_YB), (float*)(ws + WS_HU), (float*)(ws + WS_HD), args.in[8], args.in[9], args.in[10]};
}
__device__ __forceinline__ void p2_phase(const Args& args, LAS unsigned char* lds, int tid, int wave, int lane, int bx, int G) {
    const MixArgs m = make_mix(args);
#define PIDX_ROUND(r) { const int k = ((r) & 1) ? (G - 1 - bx) : bx; const int u = (r) * G + k; if (u < 2048) pidx_unit(m, lds, tid, wave, lane, u & 7, 255 - (u >> 3)); }
    PIDX_ROUND(0) PIDX_ROUND(1) PIDX_ROUND(2) PIDX_ROUND(3) PIDX_ROUND(4) PIDX_ROUND(5) PIDX_ROUND(6) PIDX_ROUND(7)
#undef PIDX_ROUND
    for (int u = bx; u < 480; u += G) { const int bh = u / 15, c = u % 15; hgrn_unit<false>(m, lds, tid, wave, lane, bh >> 2, bh & 3, c); }
}
__device__ __forceinline__ void p3_phase(const Args& args, LAS unsigned char* lds, int tid, int wave, int lane, int bx, int G) {
    const MixArgs m = make_mix(args);
    int round = 0;
    for (int base = 0; base < 1024; base += G, ++round) { const int k = (round & 1) ? (G - 1 - bx) : bx; const int u = base + k; if (u < 1024) { const int qb = 15 - (u >> 6), bhh = u & 63; attn_unit(m, lds, tid, wave, lane, bhh >> 3, bhh & 7, qb); } }
    for (int u = bx; u < 512; u += G) { const int bh = u >> 4, c = u & 15; hgrn_unit<true>(m, lds, tid, wave, lane, bh >> 2, bh & 3, 15 - c); }
}

__global__ void __launch_bounds__(512, 2) mk_fwd(Args args) {
    extern __shared__ __attribute__((aligned(16))) unsigned char lds_raw[];
    LAS unsigned char* lds = (LAS unsigned char*)lds_raw;
    volatile LAS unsigned* MISC = (volatile LAS unsigned*)(lds + MISC_OFF);
    const int tid = threadIdx.x, lane = tid & 63, wave = __builtin_amdgcn_readfirstlane(tid >> 6);
    const int G = gridDim.x; const int bx = blockIdx.x; const int vcu = (G % 8 == 0) ? (bx % 8) * (G / 8) + bx / 8 : bx;
    unsigned char* ws = args.ws;
    unsigned* ctl = (unsigned*)(ws + WS_CTL);
    for (int u = tid; u < (LDS_BYTES - RING_BYTES) / 4; u += 512) ((LAS unsigned*)(lds + RING_BYTES))[u] = 0u;
    __syncthreads();
    XcdBarrier bar; bar.bar = ctl + CW_BAR; bar.x = 0; bar.st = nullptr;
    if (MK_N_LAUNCHES == 1) bar = xcd_barrier_post(ctl + CW_BAR, MISC + 8);
    const int lo = args.ph_lo, hi = args.ph_hi;
#define IN(k) (lo <= (k) && (k) < hi)
#define SEAM(k) do { if (IN(k) && IN((k) + 1)) xcd_barrier(bar); } while (0)

    bf16* const WIN = (bf16*)(ws + WS_WIN); bf16* const WV = (bf16*)(ws + WS_WV); bf16* const WUA = (bf16*)(ws + WS_WUA); bf16* const WUB = (bf16*)(ws + WS_WUB);
    bf16* const WO = (bf16*)(ws + WS_WO); bf16* const WGU = (bf16*)(ws + WS_WGU); bf16* const WDN = (bf16*)(ws + WS_WDN);
    bf16* const XN = (bf16*)(ws + WS_XN); bf16* const PROJ = (bf16*)(ws + WS_PROJ); bf16* const VT = (bf16*)(ws + WS_VT);
    bf16* const YA = (bf16*)(ws + WS_YA); bf16* const YB = (bf16*)(ws + WS_YB); bf16* const MRG = (bf16*)(ws + WS_MRG);
    bf16* const ACT = (bf16*)(ws + WS_ACT); bf16* const YEXP = (bf16*)(ws + WS_YEXP);
    int* const TOKL = (int*)(ws + WS_TOKL); u32x2* const TOKI = (u32x2*)(ws + WS_TOKI);
    unsigned* const CNT = ctl + CW_CNT;

    if (IN(0)) {
        P0Args a{args.in[0], args.in[1], args.in[2], args.in[3], args.in[4], args.in[5], args.in[13], args.in[15], ws};
        p0_prologue(a, lds, wave, lane, vcu, G);
    }
    SEAM(0);
    if (IN(1)) {
        { pg8::StaticSched S; S.init(XN, WIN, T, NPJ, DM, G, bx); pg8::EpiBf16 E{PROJ, NPJ, nullptr, 0}; pg8::gemm_phase(lds, DM, S, E); }
        { pg8::StaticSched S; S.init(WV, XN, 512, T, DM, G, bx); pg8::EpiBf16 E{VT, T, nullptr, 0}; pg8::gemm_phase(lds, DM, S, E); }
    }
    SEAM(1);
    if (IN(2)) {
#ifdef HAVE_MIX
        p2_phase(args, lds, tid, wave, lane, bx, G);
#endif
    }
    SEAM(2);
    if (IN(3)) {
#ifdef HAVE_MIX
        p3_phase(args, lds, tid, wave, lane, bx, G);
#endif
    }
    SEAM(3);
#ifndef DBG_NOMIX
    if (IN(4)) {
        { pg8::StaticSched S; S.init(YA, WUA, T, DM, 512, G, bx); pg8::EpiMerge<true> E{PROJ + C_GA, MRG}; pg8::gemm_phase(lds, 512, S, E); }
        { pg8::StaticSched S; S.init(YB, WUB, T, DM, 512, G, bx); pg8::EpiMerge<false> E{PROJ + C_GB, MRG}; pg8::gemm_phase(lds, 512, S, E); }
    }
#ifndef DBG_NOMIX
    SEAM(4);
#endif
    if (IN(5)) {
        pg8::StaticSched S; S.init(MRG, WO, T, DM, DM, G, bx); pg8::EpiOutRes E{args.in[0], args.out}; pg8::gemm_phase(lds, DM, S, E);
    }
#else
    SEAM(4);
    if (IN(5)) { for (int m = vcu * 8 + wave; m < T; m += G * 8) { const f32x4* xr = (const f32x4*)(args.in[0] + (size_t)m * DM) + lane; f32x4* orow = (f32x4*)(args.out + (size_t)m * DM) + lane;
        for (int j = 0; j < 4; ++j) orow[64 * j] = xr[64 * j]; } }
#endif
    SEAM(5);
    if (IN(6)) {
        P6Args a{args.out, args.in[6], args.in[11], args.in[12], XN, CNT, TOKL, TOKI};
        p6_router(a, lds, tid, wave, lane, vcu, G);
    }
    SEAM(6);
    if (IN(7) || IN(8)) {
        LAS int* tstart = (LAS int*)(lds + RING_BYTES + 16);
        if (tid == 0) { int acc = 0; for (int e = 0; e < NEXP; ++e) { tstart[e] = acc; acc += ((int)__hip_atomic_load(CNT + 16 * e, __ATOMIC_RELAXED, __HIP_MEMORY_SCOPE_AGENT) + 255) / 256; } tstart[NEXP] = acc; }
        __syncthreads();
        if (IN(7)) {
            pg8::MoeSched<true> S{XN, WGU, TOKL, (const int*)CNT, tstart, DM, 8, 2 * DFF, G, bx};
            pg8::EpiSwiGLU E{args.in[14], ACT}; pg8::gemm_phase(lds, DM, S, E);
        }
        SEAM(7);
        if (IN(8)) {
            pg8::MoeSched<false> S{ACT, WDN, TOKL, (const int*)CNT, tstart, DFF, 4, DM, G, bx};
            pg8::EpiBf16 E{YEXP, DM, args.in[16], DM}; pg8::gemm_phase(lds, DFF, S, E);
        }
    }
    SEAM(8);
    if (IN(9)) p9_final(args.out, YEXP, TOKI, CNT, args.in[7], lds, tid, wave, lane, vcu, G);
#undef IN
#undef SEAM
}

#if DBG_STAGE >= 0
__device__ __forceinline__ float block_sum256(float v, float* sh) {
    v = wave_sum(v); if ((threadIdx.x & 63) == 0) sh[threadIdx.x >> 6] = v; __syncthreads();
    float r = 0.f; for (int i = 0; i < (int)(blockDim.x >> 6); ++i) r += sh[i]; __syncthreads(); return r;
}
__device__ __forceinline__ void dbg_report(unsigned* ctl, float err) { if (threadIdx.x == 0) atomicMax(ctl + CW_DBG, __float_as_uint(fabsf(err))); }
__global__ void dbg_fill(float* out, const unsigned* ctl) {
    const float e = __uint_as_float(ctl[CW_DBG]); const float K = 10.f * sqrtf(fminf(e, 1e4f));
    for (size_t i = (size_t)blockIdx.x * blockDim.x + threadIdx.x; i < (size_t)T * DM; i += (size_t)gridDim.x * blockDim.x) out[i] = K;
}
__global__ void dbg_check1(Args a) {
    __shared__ float sh[8];
    const unsigned s = blockIdx.x; const int row = (int)((s * 2654435761u) % (unsigned)T); const int tid = threadIdx.x;
    const float* x = a.in[0] + (size_t)row * DM; const float* g = a.in[5]; const float* w = a.in[1];
    float ss = 0.f; for (int k = tid; k < DM; k += 256) ss += x[k] * x[k];
    ss = block_sum256(ss, sh); const float rstd = rsqrtf(ss / DM + EPS);
    const bool isv = (s & 7) == 7; int n, sc;
    if (isv) { n = (int)((s * 40503u + 17u) % 512u); sc = 1024 + n; } else { n = (int)((s * 40503u + 17u) % 5416u); sc = srccol_in(n); }
    float acc = 0.f; for (int k = tid; k < DM; k += 256) acc += x[k] * rstd * g[k] * w[(size_t)k * 5928 + sc];
    acc = block_sum256(acc, sh);
    const bf16* PROJ = (const bf16*)(a.ws + WS_PROJ); const bf16* VT = (const bf16*)(a.ws + WS_VT);
    const float got = isv ? bf2f(VT[(size_t)n * T + row]) : bf2f(PROJ[(size_t)row * NPJ + n]);
    dbg_report((unsigned*)(a.ws + WS_CTL), got - acc);
}
__global__ void dbg_check9(Args a) {
    __shared__ float h2[1024], gu[2048], act[1024], ysum[1024], lg[32], gt[4], sh[8]; __shared__ int te[4];
    const unsigned s = blockIdx.x; const int t = (int)((s * 2654435761u) % (unsigned)T); const int tid = threadIdx.x;
    const float* x = a.in[0] + (size_t)t * DM;
    float ss = 0.f; for (int k = tid; k < DM; k += 256) ss += x[k] * x[k];
    ss = block_sum256(ss, sh); const float rstd = rsqrtf(ss / DM + EPS);
    for (int k = tid; k < DM; k += 256) { h2[k] = x[k] * rstd * a.in[6][k]; ysum[k] = 0.f; }
    __syncthreads();
    if (tid < 32) { float acc = 0.f; for (int k = 0; k < DM; ++k) acc += h2[k] * a.in[11][(size_t)k * 32 + tid]; lg[tid] = acc + a.in[12][tid]; }
    __syncthreads();
    if (tid == 0) { float v[32]; for (int e = 0; e < 32; ++e) v[e] = lg[e]; float tv[4];
        for (int k = 0; k < 4; ++k) { int be = 0; for (int e = 1; e < 32; ++e) if (lg[e] > lg[be]) be = e; te[k] = be; tv[k] = lg[be]; lg[be] = -INFINITY; }
        float den = 0.f; for (int k = 0; k < 4; ++k) den += expf(tv[k] - tv[0]); for (int k = 0; k < 4; ++k) gt[k] = expf(tv[k] - tv[0]) / den; (void)v; }
    __syncthreads();
    for (int k4 = 0; k4 < 4; ++k4) { const int e = te[k4];
        const float* wg = a.in[13] + (size_t)e * DM * 2048; const float* wd = a.in[15] + (size_t)e * DFF * DM;
        for (int n = tid; n < 2048; n += 256) { float acc = 0.f; for (int k = 0; k < DM; ++k) acc += h2[k] * wg[(size_t)k * 2048 + n]; gu[n] = acc + a.in[14][e * 2048 + n]; }
        __syncthreads();
        for (int j = tid; j < DFF; j += 256) { const float g = fminf(gu[j], 7.f), l = fminf(fmaxf(gu[1024 + j], -7.f), 7.f); act[j] = (l + 1.f) * g / (1.f + expf(-1.702f * g)); }
        __syncthreads();
        for (int n = tid; n < DM; n += 256) { float acc = 0.f; for (int j = 0; j < DFF; ++j) acc += act[j] * wd[(size_t)j * DM + n]; ysum[n] += gt[k4] * (acc + a.in[16][e * DM + n]); }
        __syncthreads();
    }
    float s2 = 0.f; for (int k = tid; k < DM; k += 256) { const float v = x[k] + ysum[k]; s2 += v * v; }
    s2 = block_sum256(s2, sh); const float r2 = rsqrtf(s2 / DM + EPS);
    float me = 0.f; for (int k = tid; k < DM; k += 256) { const float ref = (x[k] + ysum[k]) * r2 * a.in[7][k]; me = fmaxf(me, fabsf(a.out[(size_t)t * DM + k] - ref)); }
    atomicMax((unsigned*)(a.ws + WS_CTL) + CW_DBG, __float_as_uint(me));
}
#if DBG_STAGE == 1
#define DBG_KERNEL dbg_check1
#elif DBG_STAGE == 9
#define DBG_KERNEL dbg_check9
#endif
static void dbg_launch(Args a, hipStream_t stream) {
    hipLaunchKernelGGL(DBG_KERNEL, dim3(256), dim3(256), 0, stream, a);
    hipLaunchKernelGGL(dbg_fill, dim3(2048), dim3(256), 0, stream, a.out, (const unsigned*)(a.ws + WS_CTL));
}
#endif

extern "C" void kernel_launch(void* const* d_in, const int* in_sizes, int n_in, void* d_out, int out_size, void* d_ws, size_t ws_size, hipStream_t stream) {
    static int grid = 0;
    if (grid == 0) {
        if (n_in != 17 || out_size != T * DM || ws_size < WS_END) { fprintf(stderr, "kernel_launch: unexpected shapes (n_in %d out %d ws %zu, need %zu)\n", n_in, out_size, ws_size, (size_t)WS_END); grid = -1; return; }
        int dev = 0, cus = 0, per_cu = 0;
        if (hipGetDevice(&dev) != hipSuccess || hipDeviceGetAttribute(&cus, hipDeviceAttributeMultiprocessorCount, dev) != hipSuccess) { grid = -1; return; }
        if (hipFuncSetAttribute((const void*)mk_fwd, hipFuncAttributeMaxDynamicSharedMemorySize, LDS_BYTES) != hipSuccess) { fprintf(stderr, "kernel_launch: hipFuncSetAttribute failed\n"); grid = -1; return; }
        if (hipOccupancyMaxActiveBlocksPerMultiprocessor(&per_cu, (const void*)mk_fwd, 512, LDS_BYTES) != hipSuccess || per_cu < 1) fprintf(stderr, "kernel_launch: occupancy query says %d\n", per_cu);
        (void)hipGetLastError();
        grid = cus;
    }
    if (grid < 0) return;
    (void)hipMemsetAsync((char*)d_ws + WS_CTL, 0, CTL_ZERO_BYTES, stream);
    Args a{};
    for (int i = 0; i < 17; ++i) a.in[i] = (const float*)d_in[i];
    a.out = (float*)d_out; a.ws = (unsigned char*)d_ws;
#if DBG_STAGE >= 0
    const int last = DBG_STAGE + 1;
#else
    const int last = NPHASE;
#endif
    if (MK_N_LAUNCHES == 1) { a.ph_lo = 0; a.ph_hi = last; hipLaunchKernelGGL(mk_fwd, dim3(grid), dim3(512), LDS_BYTES, stream, a); }
    else for (int p = 0; p < last; ++p) { a.ph_lo = p; a.ph_hi = p + 1; hipLaunchKernelGGL(mk_fwd, dim3(grid), dim3(512), LDS_BYTES, stream, a); }
#if DBG_STAGE >= 0
    dbg_launch(a, stream);
#endif
}
```

```cpp
#define MOE_F8 1
#include <hip/hip_runtime.h>
#include <cstdio>
#include <cstdint>

#ifndef MK_N_LAUNCHES
#define MK_N_LAUNCHES 1
#endif
#ifndef MOE_F8
#define MOE_F8 0
#endif
#ifndef DBG_STAGE
#define DBG_STAGE -1
#endif

#define GAS __attribute__((address_space(1)))
#define LAS __attribute__((address_space(3)))
typedef unsigned short bf16;
typedef short bf16x8 __attribute__((ext_vector_type(8)));
typedef short s16x4 __attribute__((ext_vector_type(4)));
typedef float f32x2 __attribute__((ext_vector_type(2)));
typedef float f32x4 __attribute__((ext_vector_type(4)));
typedef float f32x16 __attribute__((ext_vector_type(16)));
typedef unsigned u32x2 __attribute__((ext_vector_type(2)));
typedef unsigned u32x4 __attribute__((ext_vector_type(4)));

constexpr int BATCH = 8, SEQ = 4096, DM = 1024, T = BATCH * SEQ;
constexpr int NPJ = 5632;
constexpr int C_AQ = 0, C_AK = 512, C_IQ = 1024, C_BQ = 1280, C_BF = 1792, C_BI = 2304, C_BG = 2816, C_GA = 3328, C_GB = 4352, C_IW = 5376, C_IK = 5384;
constexpr int NEXP = 32, DFF = 1024, TOPK = 4;
constexpr float EPS = 1e-6f;
constexpr int NPHASE = 10;
constexpr int F8P = 1024;

constexpr size_t MiB = 1u << 20;
constexpr size_t WS_CTL = 0, CTL_ZERO_BYTES = 1 * MiB;
constexpr size_t WS_WRH = 1 * MiB, WS_WRL = 1 * MiB + 65536;
constexpr size_t WS_WIN = 2 * MiB, WS_WV = 13 * MiB, WS_WUA = 14 * MiB, WS_WUB = 15 * MiB, WS_WO = 16 * MiB, WS_WGU = 18 * MiB, WS_WDN = 146 * MiB;
constexpr size_t WS_TOKL = 210 * MiB, WS_TOKI = 214 * MiB, WS_XN = 216 * MiB, WS_PROJ = 280 * MiB;
constexpr size_t WS_E = 632 * MiB;
constexpr size_t WS_VT = WS_E, WS_MASK = WS_E + 32 * MiB, WS_YA = WS_E + 48 * MiB, WS_YB = WS_E + 80 * MiB, WS_MRG = WS_E + 112 * MiB, WS_HU = WS_E + 176 * MiB, WS_HD = WS_E + 208 * MiB;
constexpr size_t WS_ACT = WS_PROJ, WS_YEXP = WS_E;
constexpr size_t WS_END = 904 * MiB;
constexpr int CW_TMO = 0, CW_CODE = 1, CW_CNT = 64  , CW_DBG = 1024, CW_TICK = 2048  , CW_BAR = 4096;

constexpr int RING_BYTES = 131072, MISC_OFF = RING_BYTES + 320, LDS_BYTES = 147456;

#ifdef WEIGHTS_IN_GLOBALS
__device__ unsigned char g_wgu8[(size_t)32 * 2048 * 1024];
__device__ unsigned char g_wdn8[(size_t)32 * 1024 * 1024];
#endif
struct Args { const float* in[17]; float* out; unsigned char* ws; int ph_lo, ph_hi, sub, pad; };
__device__ __forceinline__ unsigned cvt_pk_bf16(float lo, float hi) { unsigned r; asm volatile("v_cvt_pk_bf16_f32 %0, %1, %2" : "=v"(r) : "v"(lo), "v"(hi)); return r; }
__device__ __forceinline__ unsigned cvt4_fp8(float a, float b, float c, float d) { unsigned w = 0u; w = (unsigned)__builtin_amdgcn_cvt_pk_fp8_f32(a, b, (int)w, false); w = (unsigned)__builtin_amdgcn_cvt_pk_fp8_f32(c, d, (int)w, true); return w; }
__device__ __forceinline__ float bf2f(unsigned short b) { return __uint_as_float((unsigned)b << 16); }
__device__ __forceinline__ float bflo(unsigned w) { return __uint_as_float(w << 16); }
__device__ __forceinline__ float bfhi(unsigned w) { return __uint_as_float(w & 0xffff0000u); }
__device__ __forceinline__ float sigmoidf_(float x) { return __builtin_amdgcn_rcpf(1.0f + __expf(-x)); }
__device__ __forceinline__ float wave_sum(float v) {
#pragma unroll
    for (int o = 1; o < 64; o <<= 1) v += __shfl_xor(v, o);
    return v;
}
#define LDS_WAIT() asm volatile("s_waitcnt lgkmcnt(0)" ::: "memory")
#define VM_WAIT() asm volatile("s_waitcnt vmcnt(0)" ::: "memory")

#define XB_TMO      128
#define XB_XCNT(j)  (256  + 64 * (j))
#define XB_XSUB(j)  (1280 + 64 * (j))
#define XB_XGEN(j)  (2304 + 64 * (j))
#define XB_TOP      3328
#define XB_TOPGEN   3392
#define XCD_BAR_WORDS 3456
#define XB_SPIN_CAP (1u << 18)
__device__ __forceinline__ unsigned xb_ld(unsigned* p)              { return __hip_atomic_load(p, __ATOMIC_RELAXED, __HIP_MEMORY_SCOPE_AGENT); }
__device__ __forceinline__ unsigned xb_add(unsigned* p, unsigned v) { return __hip_atomic_fetch_add(p, v, __ATOMIC_RELAXED, __HIP_MEMORY_SCOPE_AGENT); }
__device__ __forceinline__ unsigned xb_xcc_id() { return (unsigned)__builtin_amdgcn_s_getreg((3 << 11) | 20) & 0xFu; }
#define XB_SPIN(cond, bar) do { unsigned _sp = 0; while (cond) { __builtin_amdgcn_s_sleep(1); \
    if ((++_sp & 255u) == 0u) { if (xb_ld(&(bar)[XB_TMO])) break; if (_sp > XB_SPIN_CAP) { atomicAdd(&(bar)[XB_TMO], 1u); break; } } } } while (0)
struct XcdBarrier { unsigned* bar; unsigned x; volatile LAS unsigned* st; };
__device__ __forceinline__ XcdBarrier xcd_barrier_post(unsigned* bar, volatile LAS unsigned* st) {
    XcdBarrier b; b.bar = bar; b.x = xb_xcc_id(); b.st = st;
    if (threadIdx.x == 0) (void)xb_add(&bar[XB_XCNT(b.x)], 1u);
    return b;
}
__device__ __forceinline__ void xcd_barrier_complete(unsigned* bar, unsigned x, unsigned& nloc, unsigned& nx) {
    const unsigned G = gridDim.x * gridDim.y * gridDim.z;
    unsigned sum, cnt, mine, sp = 0u;
    for (;;) {
        sum = 0u; cnt = 0u; mine = 0u;
#pragma unroll
        for (unsigned j = 0; j < 16; ++j) { const unsigned c = xb_ld(&bar[XB_XCNT(j)]); sum += c; cnt += (c > 0u) ? 1u : 0u; mine = (j == x) ? c : mine; }
        if (sum == G) break;
        __builtin_amdgcn_s_sleep(1);
        if ((++sp & 255u) == 0u) { if (xb_ld(&bar[XB_TMO])) break; if (sp > XB_SPIN_CAP) { atomicAdd(&bar[XB_TMO], 1u); break; } }
    }
    nloc = mine > 0u ? mine : 1u; nx = cnt > 0u ? cnt : 1u;
}
__device__ __forceinline__ void xcd_barrier(const XcdBarrier& b) {
    asm volatile("s_waitcnt vmcnt(0)" ::: "memory");
    __syncthreads();
    if (threadIdx.x == 0) {
        unsigned* bar = b.bar;
        __builtin_amdgcn_s_waitcnt(0);
        unsigned nloc = b.st[0], nx = b.st[1];
        if (nloc == 0u) { xcd_barrier_complete(bar, b.x, nloc, nx); b.st[0] = nloc; b.st[1] = nx; }
        const unsigned old = xb_add(&bar[XB_XSUB(b.x)], 1u);
        const unsigned gen = old / nloc;
        if (old + 1u == (gen + 1u) * nloc) {
            __builtin_amdgcn_fence(__ATOMIC_RELEASE, "agent");
            asm volatile("s_waitcnt vmcnt(0)" ::: "memory");
            const unsigned og = xb_add(&bar[XB_TOP], 1u);
            const unsigned tg = og / nx;
            if (og + 1u == (tg + 1u) * nx) xb_add(&bar[XB_TOPGEN], 1u);
            else XB_SPIN(xb_ld(&bar[XB_TOPGEN]) == tg, bar);
            __builtin_amdgcn_fence(__ATOMIC_ACQUIRE, "agent");
            xb_add(&bar[XB_XGEN(b.x)], 1u);
            asm volatile("s_waitcnt vmcnt(0)" ::: "memory");
        } else {
            XB_SPIN(xb_ld(&bar[XB_XGEN(b.x)]) == gen, bar);
            __builtin_amdgcn_fence(__ATOMIC_ACQUIRE, "agent");
            asm volatile("s_waitcnt vmcnt(0)" ::: "memory");
        }
    }
    __syncthreads();
}
namespace pg8 {
constexpr int BM = 256, BK = 64, HALF = 128, HTB = HALF * BK * 2, STAGE_BYTES = 8 * HTB, NXCD = 8, WGM = 8;
__host__ __device__ __forceinline__ int lds_byte(int r, int c) { const int st = (r >> 4) * 2 + (c >> 5), rr = r & 15, cc = c & 31, ob = rr * 64 + cc * 2; return st * 1024 + (ob ^ (((ob >> 9) & 1) << 5)); }
__host__ __device__ __forceinline__ void stage_rc(int b, int& R, int& C) { const int st = b / 1024, sb = b % 1024, swz = sb ^ (((sb >> 9) & 1) << 5); R = (st >> 1) * 16 + swz / 64; C = (st & 1) * 32 + (swz % 64) / 2; }
__host__ __device__ __forceinline__ int perm32(int rho) { const int n = rho >> 4, i = rho & 15; return 8 * (i >> 2) + 4 * n + (i & 3); }

struct Unit { const char* A0; const char* B0; int orow, pn, e, rt; };

struct StaticSched {
    const bf16* A; const bf16* Bt; int K, nM, nN, nwg, G, c;
    __device__ __forceinline__ void init(const bf16* A_, const bf16* Bt_, int M, int N, int K_, int G_, int c_) { A = A_; Bt = Bt_; K = K_; nM = M / BM; nN = N / BM; nwg = nM * nN; G = G_; c = c_; }
    __device__ __forceinline__ bool next(int i, Unit& u) const {
        const long L = (long)i * G + c; if (L >= nwg) return false;
        int wgid = (int)L; { const int q = nwg / NXCD, r = nwg % NXCD, xcd = wgid % NXCD, off = wgid / NXCD; wgid = (xcd < r ? xcd * (q + 1) : r * (q + 1) + (xcd - r) * q) + off; }
        const int nig = WGM * nN, gid = wgid / nig, fm = gid * WGM, gsz = (nM - fm) < WGM ? (nM - fm) : WGM;
        const int pm = fm + ((wgid % nig) % gsz), pn = (wgid % nig) / gsz;
        u.A0 = (const char*)A + (size_t)pm * BM * K * 2; u.B0 = (const char*)Bt + (size_t)pn * BM * K * 2; u.orow = pm * BM; u.pn = pn; u.e = 0; u.rt = 0; return true;
    }
    __device__ __forceinline__ void offs(const Unit&, const int (&R)[2], const int (&C)[2], unsigned (&o)[2][2]) const {
#pragma unroll
        for (int h = 0; h < 2; ++h)
#pragma unroll
            for (int i = 0; i < 2; ++i) o[h][i] = (unsigned)((h * HALF + R[i]) * K + C[i]) * 2u;
    }
};

template <bool GATHER> struct MoeSched {
    const unsigned char* XA; const unsigned char* W; const int* toklist; const int* cnt  ; const LAS int* tstart; int K, npn, nrows_w  , G, c;
    __device__ __forceinline__ bool next(int i, Unit& u) const {
        const long L = (G % 8 == 0) ? (long)i * G + (long)(c % 8) * (G / 8) + c / 8 : (long)i * G + c; const int ntile = tstart[NEXP];
        if (L >= (long)ntile * npn) return false;
        const int rtg = (int)(L / npn), pn = (int)(L % npn);
        int e = 0;
#pragma unroll 1
        for (int k = 1; k < NEXP; ++k) e += (tstart[k] <= rtg) ? 1 : 0;
        e = __builtin_amdgcn_readfirstlane(e);
        u.e = e; u.rt = rtg - tstart[e]; u.pn = pn; u.orow = rtg * BM;
        u.A0 = GATHER ? (const char*)XA : (const char*)XA + (size_t)rtg * BM * K;
        u.B0 = (const char*)W + ((size_t)e * nrows_w + (size_t)pn * BM) * K;
        return true;
    }
    __device__ __forceinline__ void offs(const Unit& u, const int (&R)[2], const int (&C)[2], unsigned (&o)[2][2]) const {
        if (GATHER) {
            const int n = cnt[16 * u.e];
#pragma unroll
            for (int h = 0; h < 2; ++h)
#pragma unroll
                for (int i = 0; i < 2; ++i) { const int r = u.rt * BM + h * HALF + R[i]; const int tok = (r < n) ? toklist[u.e * T + r] : 0; o[h][i] = (unsigned)(tok * K + C[i] * 2); }
        } else {
#pragma unroll
            for (int h = 0; h < 2; ++h)
#pragma unroll
                for (int i = 0; i < 2; ++i) o[h][i] = (unsigned)((h * HALF + R[i]) * K + C[i] * 2);
        }
    }
};

typedef int v8i __attribute__((ext_vector_type(8)));
typedef int v4i __attribute__((ext_vector_type(4)));
__device__ __forceinline__ void glds16_s(const char* sbase, unsigned voff, unsigned lds_dst) { unsigned keep;
    asm volatile("s_mov_b32 %0, m0\n\ts_mov_b32 m0, %3\n\ts_nop 0\n\tglobal_load_lds_dwordx4 %1, %2\n\ts_mov_b32 m0, %0" : "=&s"(keep) : "v"(voff), "s"(sbase), "s"(lds_dst) : "memory"); }
template <class Epi, class Sched, bool F8 = false>
__device__ __forceinline__ void gemm_phase(LAS unsigned char* lds, const int K, const Sched& S, const Epi& E) {
    const int tid = threadIdx.x, wid = __builtin_amdgcn_readfirstlane(tid >> 6), lane = tid & 63, wr = wid >> 2, wc = wid & 3, fr = lane & 15, fq = lane >> 4;
    const int rbytes = F8 ? K : 2 * K;
    int nt = rbytes / (BK * 2); if constexpr (F8) asm volatile("" : "+s"(nt));
    int Rr[2], Cc[2]; unsigned voffB[2];
#pragma unroll
    for (int i = 0; i < 2; ++i) { int R, C; stage_rc(tid * 16 + i * 8192, R, C); Rr[i] = R; Cc[i] = C; const int Rb = Epi::PERM ? ((R & ~31) + perm32(R & 31)) : R; voffB[i] = (unsigned)(Rb * rbytes + C * 2); }
    const size_t kstep = (size_t)(BK * 2);
    const size_t hstep = (size_t)HALF * rbytes;
    const unsigned ldsw = (unsigned)wid * 1024u; const unsigned ldsbase = (unsigned)(uintptr_t)lds;
    const int aoff = F8 ? lds_byte(wr * 64 + fr, (fq & 1) * 8) + (fq >> 1) * 1024 : lds_byte(wr * 64 + fr, fq * 8);
    const int boff = F8 ? lds_byte(wc * 32 + fr, (fq & 1) * 8) + (fq >> 1) * 1024 : lds_byte(wc * 32 + fr, fq * 8);
    const int aoff2 = aoff ^ 32; int boffH = boff + 4 * HTB, boffH2 = (boff ^ 32) + 4 * HTB; if constexpr (F8) asm volatile("" : "+v"(boffH), "+v"(boffH2));
#define PG8_SA(b, h) (((b) * 2 + (h)) * HTB)
#define PG8_SB(b, h) ((4 + (b) * 2 + (h)) * HTB)
#define PG8_STAGE(bufoff, gbase, voff) do { _Pragma("unroll") for (int _i = 0; _i < 2; ++_i) \
        { if constexpr (F8) glds16_s((gbase), (voff)[_i], (unsigned)__builtin_amdgcn_readfirstlane((int)(ldsbase + (unsigned)(bufoff) + ldsw + _i * 8192u))); \
          else __builtin_amdgcn_global_load_lds((const unsigned*)((const char*)(gbase) + (voff)[_i]), (LAS unsigned*)(lds + (bufoff) + ldsw + _i * 8192), 16, 0, 0); } } while (0)
#define PG8_LD8(v, o1, o2, cst) do { v.lo = *(const LAS v4i*)(lds + (o1) + (cst)); v.hi = *(const LAS v4i*)(lds + (o2) + (cst)); } while (0)
#define PG8_LDA(dst, b, h) do { if constexpr (F8) { PG8_LD8(A80, aoff, aoff2, PG8_SA(b, h)); PG8_LD8(A81, aoff, aoff2, PG8_SA(b, h) + 2048); PG8_LD8(A82, aoff, aoff2, PG8_SA(b, h) + 4096); PG8_LD8(A83, aoff, aoff2, PG8_SA(b, h) + 6144); } \
        else { _Pragma("unroll") for (int m = 0; m < 4; ++m) _Pragma("unroll") for (int k = 0; k < 2; ++k) dst[m][k] = *(const LAS bf16x8*)(lds + PG8_SA(b, h) + aoff + m * 2048 + k * 1024); } } while (0)
#define PG8_LDB(dst, b, h) do { if constexpr (F8) { PG8_LD8(dst##80, boffH, boffH2, PG8_SA(b, h)); PG8_LD8(dst##81, boffH, boffH2, PG8_SA(b, h) + 2048); } \
        else { _Pragma("unroll") for (int n = 0; n < 2; ++n) _Pragma("unroll") for (int k = 0; k < 2; ++k) dst[n][k] = *(const LAS bf16x8*)(lds + PG8_SA(b, h) + boffH + n * 2048 + k * 1024); } } while (0)
#define PG8_M8(ai, bj, m, n, a8, b8) acc[ai][bj][m][n] = __builtin_amdgcn_mfma_scale_f32_16x16x128_f8f6f4(b8, a8, acc[ai][bj][m][n], 0, 0, 0, 0x7F7F7F7F, 0, 0x7F7F7F7F)
#define PG8_MMA(ai, bj, At, Bt) do { __builtin_amdgcn_s_setprio(1); \
        if constexpr (F8) { PG8_M8(ai, bj, 0, 0, A80, Bt##80); PG8_M8(ai, bj, 0, 1, A80, Bt##81); PG8_M8(ai, bj, 1, 0, A81, Bt##80); PG8_M8(ai, bj, 1, 1, A81, Bt##81); \
                            PG8_M8(ai, bj, 2, 0, A82, Bt##80); PG8_M8(ai, bj, 2, 1, A82, Bt##81); PG8_M8(ai, bj, 3, 0, A83, Bt##80); PG8_M8(ai, bj, 3, 1, A83, Bt##81); } \
        else { _Pragma("unroll") for (int m = 0; m < 4; ++m) _Pragma("unroll") for (int n = 0; n < 2; ++n) _Pragma("unroll") for (int k = 0; k < 2; ++k) acc[ai][bj][m][n] = __builtin_amdgcn_mfma_f32_16x16x32_bf16(Bt[n][k], At[m][k], acc[ai][bj][m][n], 0, 0, 0); } \
        __builtin_amdgcn_s_setprio(0); } while (0)
#define PG8_WAIT_V(n) asm volatile("s_waitcnt vmcnt(" #n ")" ::: "memory")
#define PG8_WAIT_L(n) asm volatile("s_waitcnt lgkmcnt(" #n ")" ::: "memory")
#define PG8_BAR __builtin_amdgcn_s_barrier()
#define PG8_SCHED __builtin_amdgcn_sched_barrier(0)
    Unit cur, nxt; int ui = 0;
    if (!S.next(0, cur)) return;
    f32x4 acc[2][2][4][2];
#pragma unroll
    for (int a = 0; a < 2; ++a)
#pragma unroll
        for (int b = 0; b < 2; ++b)
#pragma unroll
            for (int m = 0; m < 4; ++m)
#pragma unroll
                for (int n = 0; n < 2; ++n) acc[a][b][m][n] = (f32x4){0.f, 0.f, 0.f, 0.f};
    bf16x8 At[4][2], B0[2][2], B1[2][2]; v8i A80, A81, A82, A83, B080, B081, B180, B181;
    unsigned cO[2][2], nO[2][2];
    S.offs(cur, Rr, Cc, cO);
    const char* cA = cur.A0; const char* cB = cur.B0;
    PG8_STAGE(PG8_SB(0, 0), cB, voffB); PG8_STAGE(PG8_SB(0, 1), cB + hstep, voffB); PG8_STAGE(PG8_SA(0, 0), cA, cO[0]); PG8_STAGE(PG8_SA(0, 1), cA, cO[1]);
    if (wr == 1) PG8_BAR;
    PG8_WAIT_V(2); PG8_BAR;
    PG8_STAGE(PG8_SB(1, 0), cB + kstep, voffB); PG8_STAGE(PG8_SA(1, 0), cA + kstep, cO[0]); PG8_STAGE(PG8_SB(1, 1), cB + hstep + kstep, voffB);
    PG8_WAIT_V(6); PG8_BAR;
    for (;;) {
        const bool has_next = S.next(ui + 1, nxt);
        const char* nA = has_next ? nxt.A0 : cA; const char* nB = has_next ? nxt.B0 : cB;
        if (has_next) { S.offs(nxt, Rr, Cc, nO);
#pragma unroll
            for (int h = 0; h < 2; ++h)
#pragma unroll
                for (int i = 0; i < 2; ++i) asm volatile("" : "+v"(nO[h][i]));
        } else {
#pragma unroll
            for (int h = 0; h < 2; ++h)
#pragma unroll
                for (int i = 0; i < 2; ++i) nO[h][i] = cO[h][i]; }
#pragma unroll 1
        for (int t = 0; t < nt; t += 2) {
            if constexpr (Epi::MIDK) { if (t == (nt >> 1)) E.mid(acc, cur, wr, wc, fr, fq); }
            const bool last = (t == nt - 2);
            const char* a1 = cA + (size_t)(t + 1) * kstep;
            const char* a2 = last ? nA : cA + (size_t)(t + 2) * kstep; const char* b2 = last ? nB : cB + (size_t)(t + 2) * kstep;
            const char* a3 = a2 + kstep; const char* b3 = b2 + kstep;
            unsigned o2[2][2];
#pragma unroll
            for (int h = 0; h < 2; ++h)
#pragma unroll
                for (int i = 0; i < 2; ++i) o2[h][i] = last ? nO[h][i] : cO[h][i];
            PG8_LDB(B0, 0, 0); PG8_LDB(B1, 0, 1); PG8_SCHED; PG8_LDA(At, 0, 0); PG8_STAGE(PG8_SA(1, 1), a1, cO[1]);
            PG8_WAIT_V(8); PG8_WAIT_L(0); PG8_BAR; PG8_MMA(0, 0, At, B0); PG8_MMA(0, 1, At, B1); PG8_BAR; PG8_SCHED;
            PG8_LDA(At, 0, 1); PG8_STAGE(PG8_SB(0, 0), b2, voffB); PG8_STAGE(PG8_SB(0, 1), b2 + hstep, voffB); PG8_STAGE(PG8_SA(0, 0), a2, o2[0]);
            PG8_WAIT_V(8); PG8_WAIT_L(0); PG8_BAR; PG8_MMA(1, 0, At, B0); PG8_MMA(1, 1, At, B1); PG8_BAR; PG8_SCHED;
            PG8_LDB(B0, 1, 0); PG8_LDB(B1, 1, 1); PG8_SCHED; PG8_LDA(At, 1, 0); PG8_STAGE(PG8_SA(0, 1), a2, o2[1]);
            PG8_WAIT_V(8); PG8_WAIT_L(0); PG8_BAR; PG8_MMA(0, 0, At, B0); PG8_MMA(0, 1, At, B1); PG8_BAR; PG8_SCHED;
            PG8_LDA(At, 1, 1); PG8_STAGE(PG8_SB(1, 0), b3, voffB); PG8_STAGE(PG8_SB(1, 1), b3 + hstep, voffB); PG8_STAGE(PG8_SA(1, 0), a3, o2[0]);
            PG8_WAIT_V(8); PG8_WAIT_L(0); PG8_BAR; PG8_MMA(1, 0, At, B0); PG8_MMA(1, 1, At, B1); PG8_BAR; PG8_SCHED;
        }
        if (wr == 0) PG8_BAR;
        E(acc, cur, wr, wc, fr, fq);
        if (!has_next) break;
#pragma unroll
        for (int a = 0; a < 2; ++a)
#pragma unroll
            for (int b = 0; b < 2; ++b)
#pragma unroll
                for (int m = 0; m < 4; ++m)
#pragma unroll
                    for (int n = 0; n < 2; ++n) acc[a][b][m][n] = (f32x4){0.f, 0.f, 0.f, 0.f};
        cur = nxt; cA = nA; cB = nB; ++ui;
#pragma unroll
        for (int h = 0; h < 2; ++h)
#pragma unroll
            for (int i = 0; i < 2; ++i) cO[h][i] = nO[h][i];
        if (wr == 1) PG8_BAR;
    }
    PG8_WAIT_V(0);
    PG8_BAR;
#undef PG8_SA
#undef PG8_SB
#undef PG8_STAGE
#undef PG8_LDA
#undef PG8_LDB
#undef PG8_MMA
#undef PG8_M8
#undef PG8_LD8
#undef PG8_WAIT_V
#undef PG8_WAIT_L
#undef PG8_BAR
#undef PG8_SCHED
}

struct EpiBf16 {
    static constexpr bool PERM = true, MIDK = false;
    bf16* O; int ldc; const float* bias; int bias_ld; float scale;
    __device__ __forceinline__ void operator()(const f32x4 (&acc)[2][2][4][2], const Unit& u, int wr, int wc, int fr, int fq) const {
        const int row0 = u.orow + wr * 64 + fr, col0 = u.pn * BM + wc * 32 + 8 * fq;
        f32x4 bv[2][2];
#pragma unroll
        for (int bj = 0; bj < 2; ++bj)
#pragma unroll
            for (int n = 0; n < 2; ++n) bv[bj][n] = bias ? *(const f32x4*)(bias + (size_t)u.e * bias_ld + col0 + bj * HALF + 4 * n) : (f32x4){0.f, 0.f, 0.f, 0.f};
#pragma unroll
        for (int ai = 0; ai < 2; ++ai)
#pragma unroll
            for (int m = 0; m < 4; ++m) { bf16* rowp = O + (size_t)(row0 + ai * HALF + m * 16) * ldc + col0;
#pragma unroll
                for (int bj = 0; bj < 2; ++bj) { const f32x4 v0 = acc[ai][bj][m][0] * scale + bv[bj][0], v1 = acc[ai][bj][m][1] * scale + bv[bj][1];
                    u32x4 w; w.x = cvt_pk_bf16(v0[0], v0[1]); w.y = cvt_pk_bf16(v0[2], v0[3]); w.z = cvt_pk_bf16(v1[0], v1[1]); w.w = cvt_pk_bf16(v1[2], v1[3]);
                    *(u32x4*)(rowp + bj * HALF) = w; } }
    }
};
struct EpiMerge2 {
    static constexpr bool PERM = true, MIDK = true;
    const bf16* Ga; const bf16* Gb; bf16* O;
    __device__ __forceinline__ void mid(f32x4 (&acc)[2][2][4][2], const Unit& u, int wr, int wc, int fr, int fq) const {
        int row0 = u.orow + wr * 64 + fr, col0 = u.pn * BM + wc * 32 + 8 * fq;
        asm volatile("" : "+v"(row0), "+v"(col0));
#pragma unroll
        for (int ai = 0; ai < 2; ++ai)
#pragma unroll
            for (int m = 0; m < 4; ++m) { const size_t r = (size_t)(row0 + ai * HALF + m * 16);
#pragma unroll
                for (int bj = 0; bj < 2; ++bj) { const u32x4 ga = *(const u32x4*)(Ga + r * NPJ + col0 + bj * HALF), gb = *(const u32x4*)(Gb + r * NPJ + col0 + bj * HALF);
                    const float a8[8] = {bflo(ga.x), bfhi(ga.x), bflo(ga.y), bfhi(ga.y), bflo(ga.z), bfhi(ga.z), bflo(ga.w), bfhi(ga.w)};
                    const float b8[8] = {bflo(gb.x), bfhi(gb.x), bflo(gb.y), bfhi(gb.y), bflo(gb.z), bfhi(gb.z), bflo(gb.w), bfhi(gb.w)};
#pragma unroll
                    for (int j = 0; j < 8; ++j) { const float ratio = (1.0f + __expf(-b8[j])) * __builtin_amdgcn_rcpf(1.0f + __expf(-a8[j])); acc[ai][bj][m][j >> 2][j & 3] *= ratio; } }
                asm volatile("" ::: "memory"); }
    }
    __device__ __forceinline__ void operator()(const f32x4 (&acc)[2][2][4][2], const Unit& u, int wr, int wc, int fr, int fq) const {
        const int row0 = u.orow + wr * 64 + fr, col0 = u.pn * BM + wc * 32 + 8 * fq;
#pragma unroll
        for (int ai = 0; ai < 2; ++ai)
#pragma unroll
            for (int m = 0; m < 4; ++m) { const size_t r = (size_t)(row0 + ai * HALF + m * 16);
#pragma unroll
                for (int bj = 0; bj < 2; ++bj) { const u32x4 gw = *(const u32x4*)(Gb + r * NPJ + col0 + bj * HALF);
                    f32x4 v0 = acc[ai][bj][m][0], v1 = acc[ai][bj][m][1];
                    v0[0] *= sigmoidf_(bflo(gw.x)); v0[1] *= sigmoidf_(bfhi(gw.x)); v0[2] *= sigmoidf_(bflo(gw.y)); v0[3] *= sigmoidf_(bfhi(gw.y));
                    v1[0] *= sigmoidf_(bflo(gw.z)); v1[1] *= sigmoidf_(bfhi(gw.z)); v1[2] *= sigmoidf_(bflo(gw.w)); v1[3] *= sigmoidf_(bfhi(gw.w));
                    u32x4 w; w.x = cvt_pk_bf16(v0[0], v0[1]); w.y = cvt_pk_bf16(v0[2], v0[3]); w.z = cvt_pk_bf16(v1[0], v1[1]); w.w = cvt_pk_bf16(v1[2], v1[3]);
                    *(u32x4*)(O + r * DM + col0 + bj * HALF) = w; } }
    }
};
struct EpiOutRes {
    static constexpr bool PERM = false, MIDK = false;
    const float* X; float* O;
    __device__ __forceinline__ void operator()(const f32x4 (&acc)[2][2][4][2], const Unit& u, int wr, int wc, int fr, int fq) const {
        const int row0 = u.orow + wr * 64 + fr, col0 = u.pn * BM + wc * 32 + 4 * fq;
#pragma unroll
        for (int ai = 0; ai < 2; ++ai)
#pragma unroll
            for (int m = 0; m < 4; ++m) { const size_t off = (size_t)(row0 + ai * HALF + m * 16) * DM + col0;
#pragma unroll
                for (int bj = 0; bj < 2; ++bj)
#pragma unroll
                    for (int n = 0; n < 2; ++n) { const f32x4 xv = *(const f32x4*)(X + off + bj * HALF + n * 16); *(f32x4*)(O + off + bj * HALF + n * 16) = xv + acc[ai][bj][m][n]; } }
    }
};
struct EpiSwiGLU {
    static constexpr bool PERM = true, MIDK = false;
    const float* bgu; unsigned char* O; float scale;
    __device__ __forceinline__ void operator()(const f32x4 (&acc)[2][2][4][2], const Unit& u, int wr, int wc, int fr, int fq) const {
        const int row0 = u.orow + wr * 64 + fr, col0 = u.pn * HALF + wc * 32 + 8 * fq;
        const float* bg = bgu + (size_t)u.e * 2 * DFF + col0;
        f32x4 bgt[2], bln[2];
#pragma unroll
        for (int n = 0; n < 2; ++n) { bgt[n] = *(const f32x4*)(bg + 4 * n); bln[n] = *(const f32x4*)(bg + DFF + 4 * n); }
#pragma unroll
        for (int ai = 0; ai < 2; ++ai)
#pragma unroll
            for (int m = 0; m < 4; ++m) { float o[8];
#pragma unroll
                for (int n = 0; n < 2; ++n) { const f32x4 gt = acc[ai][0][m][n] * scale + bgt[n], ln = acc[ai][1][m][n] * scale + bln[n];
#pragma unroll
                    for (int j = 0; j < 4; ++j) { const float gg = fminf(gt[j], 7.0f), ll = fminf(fmaxf(ln[j], -7.0f), 7.0f); o[4 * n + j] = (ll + 1.0f) * gg * sigmoidf_(1.702f * gg); } }
                if (MOE_F8) { u32x2 w; w.x = cvt4_fp8(o[0], o[1], o[2], o[3]); w.y = cvt4_fp8(o[4], o[5], o[6], o[7]); *(u32x2*)(O + (size_t)(row0 + ai * HALF + m * 16) * DFF + col0) = w; }
                else { u32x4 w; w.x = cvt_pk_bf16(o[0], o[1]); w.y = cvt_pk_bf16(o[2], o[3]); w.z = cvt_pk_bf16(o[4], o[5]); w.w = cvt_pk_bf16(o[6], o[7]); *(u32x4*)((bf16*)O + (size_t)(row0 + ai * HALF + m * 16) * DFF + col0) = w; } }
    }
};
}

namespace f8g {
#ifndef F8_AUX_A
#define F8_AUX_A 0
#endif
#ifndef F8_AUX_B
#define F8_AUX_B 0
#endif
#ifndef F8_NLOAD
#define F8_NLOAD 4
#endif
#ifndef F8_REGSTAGE
#define F8_REGSTAGE 0
#endif
constexpr int BMR = 256, BNC = 256, HT = 16384, STG = 4 * HT;
__host__ __device__ __forceinline__ int img_byte(int r, int gran) { return (r >> 3) * 1024 + (r & 7) * 128 + 16 * (gran ^ ((r >> 1) & 7)); }
__host__ __device__ __forceinline__ void img_rc(int b, int& R, int& Cb) { const int ch = b >> 10, rr = (b >> 7) & 7; R = ch * 8 + rr; Cb = 16 * (((b >> 4) & 7) ^ ((R >> 1) & 7)); }
struct Unit { const char* A0; const char* B0; int orow, pn, e, rt; };
template <bool GATHER> struct Sched {
    const unsigned char* XA; const unsigned char* W; const int* toklist; const int* cnt; const LAS int* tstart; int K  , npn, nrows_w, G, c;
    __device__ __forceinline__ bool next(int i, Unit& u) const {
        const int L = i * G + c; const int ntile = tstart[NEXP];
        if (L >= ntile * npn) return false;
        const int sh = __builtin_ctz((unsigned)npn); const int rtg = L >> sh, pn = L & (npn - 1);
        const int ln = (int)(threadIdx.x & 63); const int tv = tstart[ln < NEXP ? ln : 0];
        int e = __popcll(__ballot(ln >= 1 && ln < NEXP && tv <= rtg));
        e = __builtin_amdgcn_readfirstlane(e);
        u.e = e; u.rt = rtg - tstart[e]; u.pn = pn; u.orow = rtg * BMR;
        u.A0 = GATHER ? (const char*)XA : (const char*)XA + (size_t)rtg * BMR * F8P;
        u.B0 = (const char*)W + ((size_t)e * nrows_w + (size_t)pn * BNC) * K;
        return true;
    }
    __device__ __forceinline__ void offs(const Unit& u, const int (&R)[16 / F8_NLOAD], const int (&C)[16 / F8_NLOAD], unsigned (&o)[2][16 / F8_NLOAD]) const {
        if (GATHER) { const int n = cnt[16 * u.e];
#pragma unroll
            for (int h = 0; h < 2; ++h)
#pragma unroll
                for (int i = 0; i < 16 / F8_NLOAD; ++i) { const int r = u.rt * BMR + h * 128 + R[i]; const int tok = (r < n) ? toklist[u.e * T + r] : 0; o[h][i] = (unsigned)(tok * F8P + C[i] * 2); }
        } else {
#pragma unroll
            for (int h = 0; h < 2; ++h)
#pragma unroll
                for (int i = 0; i < 16 / F8_NLOAD; ++i) o[h][i] = (unsigned)((h * 128 + R[i]) * F8P + C[i] * 2);
        }
    }
};
typedef int v8i __attribute__((ext_vector_type(8)));
typedef int v4i __attribute__((ext_vector_type(4)));
template <class Epi, class S_, int PROBE = 0>
__device__ __forceinline__ void gemm(LAS unsigned char* lds, const int K, const S_& S, const Epi& E) {
    const int tid = threadIdx.x, wid = __builtin_amdgcn_readfirstlane(tid >> 6), lane = tid & 63, wr = wid >> 2, wc = wid & 3, fr = lane & 15, fq = lane >> 4;
    int nt = K / 128; asm volatile("" : "+s"(nt));
    const bool loader = wid < F8_NLOAD;
    int Rr[16 / F8_NLOAD], Cc[16 / F8_NLOAD]; unsigned voffB[16 / F8_NLOAD];
#pragma unroll
    for (int i = 0; i < 16 / F8_NLOAD; ++i) { int R, Cb; img_rc(((wid & (F8_NLOAD - 1)) + F8_NLOAD * i) * 1024 + lane * 16, R, Cb); Rr[i] = R; Cc[i] = Cb >> 1; voffB[i] = (unsigned)(R * 128 + Cb); }
    const unsigned ldsw = (unsigned)(wid & (F8_NLOAD - 1)) * 1024u;
    const size_t hstepB = (size_t)128 * 128;
    const int aoff = img_byte(fr, fq) + wr * HT, aoff2 = aoff ^ 64;
    const int boff = img_byte((wc & 1) * 64 + fr, fq) + (2 + (wc >> 1)) * HT, boff2 = boff ^ 64;
#define F8_STAGE(stg, abase, ao, bbase) do { if (loader) { _Pragma("unroll") for (int _i = 0; _i < 16 / F8_NLOAD; ++_i) { \
        __builtin_amdgcn_global_load_lds((const unsigned*)((abase) + (ao)[0][_i]), (LAS unsigned*)(lds + (stg) * STG + ldsw + _i * (F8_NLOAD * 1024)), 16, 0, F8_AUX_A); \
        __builtin_amdgcn_global_load_lds((const unsigned*)((abase) + (ao)[1][_i]), (LAS unsigned*)(lds + (stg) * STG + HT + ldsw + _i * (F8_NLOAD * 1024)), 16, 0, F8_AUX_A); \
        __builtin_amdgcn_global_load_lds((const unsigned*)((bbase) + voffB[_i]), (LAS unsigned*)(lds + (stg) * STG + 2 * HT + ldsw + _i * (F8_NLOAD * 1024)), 16, 0, F8_AUX_B); \
        __builtin_amdgcn_global_load_lds((const unsigned*)((bbase) + hstepB + voffB[_i]), (LAS unsigned*)(lds + (stg) * STG + 3 * HT + ldsw + _i * (F8_NLOAD * 1024)), 16, 0, F8_AUX_B); } } } while (0)
    u32x4 rg[8];
#define F8_GLOAD(abase, ao, bbase) do { _Pragma("unroll") for (int _i = 0; _i < 2; ++_i) { \
        rg[0 + _i] = *(const u32x4*)((abase) + (ao)[0][_i]); rg[2 + _i] = *(const u32x4*)((abase) + (ao)[1][_i]); \
        rg[4 + _i] = *(const u32x4*)((bbase) + voffB[_i]); rg[6 + _i] = *(const u32x4*)((bbase) + hstepB + voffB[_i]); } } while (0)
#define F8_LSTORE(stg) do { _Pragma("unroll") for (int _i = 0; _i < 2; ++_i) { const unsigned o_ = (stg) * STG + ldsw + _i * 8192 + (unsigned)lane * 16u; \
        *(LAS u32x4*)(lds + o_) = rg[0 + _i]; *(LAS u32x4*)(lds + o_ + HT) = rg[2 + _i]; *(LAS u32x4*)(lds + o_ + 2 * HT) = rg[4 + _i]; *(LAS u32x4*)(lds + o_ + 3 * HT) = rg[6 + _i]; } } while (0)
    Unit cur, nxt; int ui = 0;
    if (!S.next(0, cur)) return;
    f32x4 acc[8][4];
#pragma unroll
    for (int m = 0; m < 8; ++m)
#pragma unroll
        for (int n = 0; n < 4; ++n) acc[m][n] = (f32x4){0.f, 0.f, 0.f, 0.f};
    unsigned cO[2][16 / F8_NLOAD], nO[2][16 / F8_NLOAD];
    S.offs(cur, Rr, Cc, cO);
#if F8_REGSTAGE
    F8_GLOAD(cur.A0, cO, cur.B0); F8_LSTORE(0);
#else
    F8_STAGE(0, cur.A0, cO, cur.B0);
#endif
    int stg = 0;
    for (;;) {
        const bool has_next = S.next(ui + 1, nxt);
        if (has_next) { S.offs(nxt, Rr, Cc, nO);
#pragma unroll
            for (int h = 0; h < 2; ++h)
#pragma unroll
                for (int i = 0; i < 16 / F8_NLOAD; ++i) asm volatile("" : "+v"(nO[h][i])); }
        else {
#pragma unroll
            for (int h = 0; h < 2; ++h)
#pragma unroll
                for (int i = 0; i < 16 / F8_NLOAD; ++i) nO[h][i] = cO[h][i]; }
#pragma unroll 1
        for (int t = 0; t < nt; ++t) {
#if F8_REGSTAGE
            __syncthreads();
#else
            asm volatile("s_waitcnt vmcnt(0)" ::: "memory"); __builtin_amdgcn_s_barrier();
#endif
            { const int t2 = t + 1; const bool wrap = t2 >= nt; const char* ab = wrap ? (has_next ? nxt.A0 : cur.A0) : cur.A0; const char* bb = wrap ? (has_next ? nxt.B0 : cur.B0) : cur.B0;
              const int kb = wrap ? 0 : t2 * 128; unsigned o2[2][16 / F8_NLOAD];
#pragma unroll
              for (int h = 0; h < 2; ++h)
#pragma unroll
                  for (int i = 0; i < 16 / F8_NLOAD; ++i) o2[h][i] = wrap ? nO[h][i] : cO[h][i];
#if F8_REGSTAGE
              F8_GLOAD(ab + kb, o2, bb + (size_t)kb * 256); }
#else
              F8_STAGE(stg ^ 1, ab + kb, o2, bb + (size_t)kb * 256); }
#endif
            const LAS unsigned char* sb = lds + stg * STG;
            if (PROBE == 2) { stg ^= 1; continue; }
            v8i B8[4];
#pragma unroll
            for (int n = 0; n < 4; ++n) { B8[n].lo = *(const LAS v4i*)(sb + boff + n * 2048); B8[n].hi = *(const LAS v4i*)(sb + boff2 + n * 2048); }
            v8i A8c, A8n; A8c.lo = *(const LAS v4i*)(sb + aoff); A8c.hi = *(const LAS v4i*)(sb + aoff2);
#pragma unroll
            for (int m = 0; m < 8; ++m) {
                if (m < 7) { A8n.lo = *(const LAS v4i*)(sb + aoff + (m + 1) * 2048); A8n.hi = *(const LAS v4i*)(sb + aoff2 + (m + 1) * 2048); }
                __builtin_amdgcn_s_setprio(1);
#pragma unroll
                for (int n = 0; n < 4; ++n) { if (PROBE == 1) { acc[m][n][0] += __int_as_float(B8[n][0] ^ A8c[0]); acc[m][n][1] += __int_as_float(B8[n][7] ^ A8c[7]); } else acc[m][n] = __builtin_amdgcn_mfma_scale_f32_16x16x128_f8f6f4(B8[n], A8c, acc[m][n], 0, 0, 0, 0x7F7F7F7F, 0, 0x7F7F7F7F); }
                __builtin_amdgcn_s_setprio(0);
                A8c = A8n; }
#if F8_REGSTAGE
            F8_LSTORE(stg ^ 1);
#endif
            stg ^= 1;
        }
        E(acc, cur, wr, wc, fr, fq);
        if (!has_next) break;
#pragma unroll
        for (int m = 0; m < 8; ++m)
#pragma unroll
            for (int n = 0; n < 4; ++n) acc[m][n] = (f32x4){0.f, 0.f, 0.f, 0.f};
        cur = nxt; ++ui;
#pragma unroll
        for (int h = 0; h < 2; ++h)
#pragma unroll
            for (int i = 0; i < 16 / F8_NLOAD; ++i) cO[h][i] = nO[h][i];
    }
    asm volatile("s_waitcnt vmcnt(0)" ::: "memory"); __builtin_amdgcn_s_barrier();
#undef F8_STAGE
#undef F8_GLOAD
#undef F8_LSTORE
}
struct EpiSwiGLU8 {
    const float* bgu; unsigned char* O;
    __device__ __forceinline__ void operator()(const f32x4 (&acc)[8][4], const Unit& u, int wr, int wc, int fr, int fq) const {
        const int row0 = u.orow + wr * 128 + fr, col0 = u.pn * 128 + wc * 32 + 4 * fq;
        const float* bg = bgu + (size_t)u.e * 2 * DFF + col0;
        f32x4 bgt[2], bln[2];
#pragma unroll
        for (int n = 0; n < 2; ++n) { bgt[n] = *(const f32x4*)(bg + 16 * n); bln[n] = *(const f32x4*)(bg + DFF + 16 * n); }
#pragma unroll
        for (int m = 0; m < 8; ++m)
#pragma unroll
            for (int n = 0; n < 2; ++n) { const f32x4 gt = acc[m][n] * (1.f / 32.f) + bgt[n], ln = acc[m][2 + n] * (1.f / 32.f) + bln[n]; float o[4];
#pragma unroll
                for (int j = 0; j < 4; ++j) { const float gg = fminf(gt[j], 7.0f), ll = fminf(fmaxf(ln[j], -7.0f), 7.0f); o[j] = (ll + 1.0f) * gg * sigmoidf_(1.702f * gg); }
                *(unsigned*)(O + (size_t)(row0 + m * 16) * F8P + col0 + 16 * n) = cvt4_fp8(o[0], o[1], o[2], o[3]); }
    }
};
struct EpiDown8 {
    const float* bias; bf16* O;
    __device__ __forceinline__ void operator()(const f32x4 (&acc)[8][4], const Unit& u, int wr, int wc, int fr, int fq) const {
        const int row0 = u.orow + wr * 128 + fr, col0 = u.pn * BNC + wc * 64 + 4 * fq;
        f32x4 bv[4];
#pragma unroll
        for (int n = 0; n < 4; ++n) bv[n] = *(const f32x4*)(bias + (size_t)u.e * DM + col0 + 16 * n);
#pragma unroll
        for (int m = 0; m < 8; ++m)
#pragma unroll
            for (int n = 0; n < 4; ++n) { const f32x4 v = acc[m][n] * (1.f / 32.f) + bv[n]; u32x2 w; w.x = cvt_pk_bf16(v[0], v[1]); w.y = cvt_pk_bf16(v[2], v[3]);
                *(u32x2*)(O + (size_t)(row0 + m * 16) * DM + col0 + 16 * n) = w; }
    }
};
}
__device__ __forceinline__ int srccol_in(int n) {
    if (n < 1024) return n;
    if (n < 1280) return 1536 + (n - 1024);
    if (n < 1792) return 1832 + (n - 1280);
    if (n < 2304) return 2344 + (n - 1792);
    if (n < 2816) return 2856 + (n - 2304);
    if (n < 3328) return 3368 + (n - 2816);
    if (n < 4352) return 3880 + (n - 3328);
    if (n < 5376) return 4904 + (n - 4352);
    if (n < 5384) return 1792 + (n - 5376);
    if (n < 5416) return 1800 + (n - 5384);
    return -1;
}
template <int MAP> __device__ __forceinline__ int srccol(int n) {
    if (MAP == 1) return srccol_in(n);
    if (MAP == 2) return 1024 + n;
    if (MAP == 3) { const int pn = n >> 8, j = n & 255; return j < 128 ? pn * 128 + j : 1024 + pn * 128 + (j - 128); }
    if (MAP == 4) { const int pn = n >> 8, j = n & 255, q = j >> 5; return (q & 1 ? 1024 : 0) + 128 * pn + 32 * (q >> 1) + (j & 31); }
    return n;
}
template <int MAP, bool F8 = false> __device__ __forceinline__ void tr_item(const float* W, int ldw, int Kd  , bf16* WT, int k0, int n0, LAS float* scr, int lane) {
    const int nq = lane & 7, sc = srccol<MAP>(n0 + 4 * nq);
#pragma unroll
    for (int i = 0; i < 8; ++i) { const int kk = (lane >> 3) + 8 * i;
        f32x4 v = (f32x4){0.f, 0.f, 0.f, 0.f}; if (sc >= 0) v = *(const f32x4*)(W + (size_t)(k0 + kk) * ldw + sc);
        LAS float* d = scr + kk * 33 + 4 * nq; d[0] = v[0]; d[1] = v[1]; d[2] = v[2]; d[3] = v[3]; }
    LDS_WAIT(); asm volatile("" ::: "memory");
    const int c = lane & 7;
#pragma unroll
    for (int j = 0; j < 4; ++j) { const int n = (lane >> 3) + 8 * j; const LAS float* s = scr + (8 * c) * 33 + n;
        if (F8) { u32x2 o; o.x = cvt4_fp8(s[0 * 33] * 32.f, s[1 * 33] * 32.f, s[2 * 33] * 32.f, s[3 * 33] * 32.f); o.y = cvt4_fp8(s[4 * 33] * 32.f, s[5 * 33] * 32.f, s[6 * 33] * 32.f, s[7 * 33] * 32.f);
            const int nn = n0 + n, kk = k0 + 8 * c; *(u32x2*)((unsigned char*)WT + ((size_t)(nn >> 8) * (Kd >> 7) + (kk >> 7)) * 32768 + (size_t)(nn & 255) * 128 + (kk & 127)) = o; }
        else { u32x4 o; o.x = cvt_pk_bf16(s[0 * 33], s[1 * 33]); o.y = cvt_pk_bf16(s[2 * 33], s[3 * 33]); o.z = cvt_pk_bf16(s[4 * 33], s[5 * 33]); o.w = cvt_pk_bf16(s[6 * 33], s[7 * 33]);
            *(u32x4*)(WT + (size_t)(n0 + n) * Kd + k0 + 8 * c) = o; } }
    LDS_WAIT(); asm volatile("" ::: "memory");
}
template <int MAP, bool F8 = false> __device__ __forceinline__ void tr_matrix(const float* W, int ldw, int Kd, int Nd, bf16* WT, LAS float* scr, int lane, int gw, int NGW, int pitch = 0) {
    const int nkb = Kd / 64, nnb = Nd / 32, n = nkb * nnb; if (pitch == 0) pitch = Kd;
    for (int it = gw; it < n; it += NGW) { const int kb = it / nnb, nb = it % nnb; tr_item<MAP, F8>(W, ldw, pitch, WT, 64 * kb, 32 * nb, scr, lane); }
}
__device__ __forceinline__ void rms_row_to_bf16(const float* xrow, const float* gain, bf16* orow, int lane) {
    const f32x4* xr = (const f32x4*)xrow + lane; const f32x4* gr = (const f32x4*)gain + lane;
    f32x4 v[4]; float s = 0.f;
#pragma unroll
    for (int j = 0; j < 4; ++j) { v[j] = xr[64 * j]; s += (v[j][0] * v[j][0] + v[j][1] * v[j][1]) + (v[j][2] * v[j][2] + v[j][3] * v[j][3]); }
    const float rstd = rsqrtf(wave_sum(s) * (1.f / DM) + EPS);
    u32x2* o8 = (u32x2*)orow + lane;
#pragma unroll
    for (int j = 0; j < 4; ++j) { const f32x4 g = gr[64 * j]; u32x2 w; w.x = cvt_pk_bf16(v[j][0] * rstd * g[0], v[j][1] * rstd * g[1]); w.y = cvt_pk_bf16(v[j][2] * rstd * g[2], v[j][3] * rstd * g[3]); o8[64 * j] = w; }
}

struct P0Args { const float *x, *w_in, *w_up_a, *w_up_b, *w_out, *norm_mix, *w_gu, *w_down, *w_router; unsigned char* ws; unsigned char* wgu; unsigned char* wdn; };
__device__ __forceinline__ void p0_prologue(const P0Args& a, LAS unsigned char* lds, int wave, int lane, int vcu, int G) {
    LAS float* scr = (LAS float*)(lds + wave * 16384);
    const int gw = vcu * 8 + wave, NGW = G * 8;
    unsigned char* ws = a.ws;
    tr_matrix<1>(a.w_in, 5928, DM, NPJ, (bf16*)(ws + WS_WIN), scr, lane, gw, NGW);
    tr_matrix<2>(a.w_in, 5928, DM, 512, (bf16*)(ws + WS_WV), scr, lane, gw, NGW);
    tr_matrix<0>(a.w_up_a, DM, 512, DM, (bf16*)(ws + WS_WUA), scr, lane, gw, NGW, DM);
    tr_matrix<0>(a.w_up_b, DM, 512, DM, (bf16*)(ws + WS_WUA) + 512, scr, lane, gw, NGW, DM);
    tr_matrix<0>(a.w_out, DM, DM, DM, (bf16*)(ws + WS_WO), scr, lane, gw, NGW);
    for (int i = gw * 64 + lane; i < NEXP * DM; i += NGW * 64) { const int e = i >> 10, k = i & 1023; const float w = a.w_router[(size_t)k * NEXP + e];
        const unsigned hw = cvt_pk_bf16(w, 0.f) & 0xffffu; ((bf16*)(ws + WS_WRH))[i] = (bf16)hw; ((bf16*)(ws + WS_WRL))[i] = (bf16)(cvt_pk_bf16(w - bflo(hw), 0.f) & 0xffffu); }
    for (int m = gw; m < T; m += 4 * NGW) {
        f32x4 v[4][4]; const f32x4* gr = (const f32x4*)a.norm_mix + lane;
#pragma unroll
        for (int u = 0; u < 4; ++u) { const int r = m + u * NGW; const f32x4* xr = (const f32x4*)(a.x + (size_t)(r < T ? r : m) * DM) + lane;
#pragma unroll
            for (int j = 0; j < 4; ++j) v[u][j] = xr[64 * j]; }
#pragma unroll
        for (int u = 0; u < 4; ++u) { const int r = m + u * NGW; if (r >= T) break; float ss = 0.f;
#pragma unroll
            for (int j = 0; j < 4; ++j) ss += (v[u][j][0] * v[u][j][0] + v[u][j][1] * v[u][j][1]) + (v[u][j][2] * v[u][j][2] + v[u][j][3] * v[u][j][3]);
            const float rstd = rsqrtf(wave_sum(ss) * (1.f / DM) + EPS);
            u32x2* o8 = (u32x2*)((bf16*)(ws + WS_XN) + (size_t)r * DM) + lane;
#pragma unroll
            for (int j = 0; j < 4; ++j) { const f32x4 g = gr[64 * j]; u32x2 w; w.x = cvt_pk_bf16(v[u][j][0] * rstd * g[0], v[u][j][1] * rstd * g[1]); w.y = cvt_pk_bf16(v[u][j][2] * rstd * g[2], v[u][j][3] * rstd * g[3]); o8[64 * j] = w; } }
    }
    for (int e = 0; e < NEXP; ++e) {
        constexpr int EB = MOE_F8 ? 1 : 2;
        tr_matrix<MOE_F8 ? 4 : 3, MOE_F8 != 0>(a.w_gu + (size_t)e * DM * 2 * DFF, 2 * DFF, DM, 2 * DFF, (bf16*)(a.wgu + (size_t)e * 2 * DFF * DM * EB), scr, lane, (gw + 61 * e) % NGW, NGW);
        tr_matrix<0, MOE_F8 != 0>(a.w_down + (size_t)e * DFF * DM, DM, DFF, DM, (bf16*)(a.wdn + (size_t)e * DM * DFF * EB), scr, lane, (gw + 37 * e) % NGW, NGW);
    }
}

struct P6Args { const float* x1; const float* norm_ffn; const bf16* wrh; const bf16* wrl; const float* b_router; unsigned char* h2; unsigned* cnt; int* tokl; u32x2* toki; };
__device__ __forceinline__ void p6_split8(const f32x4 a, const f32x4 b, const f32x4 ga, const f32x4 gb, float rs, bf16x8& hi, bf16x8& lo) {
    float v[8] = {a[0] * rs * ga[0], a[1] * rs * ga[1], a[2] * rs * ga[2], a[3] * rs * ga[3], b[0] * rs * gb[0], b[1] * rs * gb[1], b[2] * rs * gb[2], b[3] * rs * gb[3]};
    u32x4 h; h.x = cvt_pk_bf16(v[0], v[1]); h.y = cvt_pk_bf16(v[2], v[3]); h.z = cvt_pk_bf16(v[4], v[5]); h.w = cvt_pk_bf16(v[6], v[7]);
    u32x4 l; l.x = cvt_pk_bf16(v[0] - bflo(h.x), v[1] - bfhi(h.x)); l.y = cvt_pk_bf16(v[2] - bflo(h.y), v[3] - bfhi(h.y)); l.z = cvt_pk_bf16(v[4] - bflo(h.z), v[5] - bfhi(h.z)); l.w = cvt_pk_bf16(v[6] - bflo(h.w), v[7] - bfhi(h.w));
    hi = __builtin_bit_cast(bf16x8, h); lo = __builtin_bit_cast(bf16x8, l);
}
__device__ __forceinline__ void p6_router(const P6Args& a, LAS unsigned char* lds, int tid, int wave, int lane, int vcu, int G) {
    LAS float* rstd_l = (LAS float*)(lds + RING_BYTES + 1024);
    LAS unsigned* lcnt = (LAS unsigned*)(lds + RING_BYTES + 2048);
    LAS unsigned* lbase = lcnt + 32;
    LAS unsigned* lsel = lcnt + 64;
    LAS float* lgate = (LAS float*)(lcnt + 64 + 512);
    const int rows_per = 128;
    for (int i = tid; i < 8192; i += 512) { const int e = (i >> 7) & 31, hl = i >> 12, kb = (i & 127) * 16;
        *(LAS u32x4*)(lds + hl * 65536 + e * 2048 + (kb ^ ((e & 15) << 4))) = *(const u32x4*)((const unsigned char*)(hl ? a.wrl : a.wrh) + e * 2048 + kb); }
    __syncthreads();
    for (int base = vcu * rows_per; base < T; base += G * rows_per) {
        if (tid < 32) lcnt[tid] = 0u;
        __syncthreads();
#pragma unroll 1
        for (int q = 0; q < 16; q += 4) {
            f32x4 v[4][4];
#pragma unroll
            for (int u = 0; u < 4; ++u) { const f32x4* xr = (const f32x4*)(a.x1 + (size_t)(base + 16 * wave + q + u) * DM) + lane;
#pragma unroll
                for (int j = 0; j < 4; ++j) v[u][j] = xr[64 * j]; }
#pragma unroll
            for (int u = 0; u < 4; ++u) { const int t = base + 16 * wave + q + u; const f32x4* gr = (const f32x4*)a.norm_ffn + lane; float s = 0.f;
#pragma unroll
                for (int j = 0; j < 4; ++j) s += (v[u][j][0] * v[u][j][0] + v[u][j][1] * v[u][j][1]) + (v[u][j][2] * v[u][j][2] + v[u][j][3] * v[u][j][3]);
                const float rstd = rsqrtf(wave_sum(s) * (1.f / DM) + EPS);
                if (lane == 0) rstd_l[wave * 16 + q + u] = rstd;
                unsigned* o4 = (unsigned*)((unsigned char*)a.h2 + (size_t)t * F8P) + lane; u32x2* o8 = (u32x2*)((bf16*)a.h2 + (size_t)t * DM) + lane;
#pragma unroll
                for (int j = 0; j < 4; ++j) { const f32x4 g = gr[64 * j]; const f32x4 y = v[u][j] * rstd * g;
                    if (MOE_F8) o4[64 * j] = cvt4_fp8(y[0], y[1], y[2], y[3]); else { u32x2 w; w.x = cvt_pk_bf16(y[0], y[1]); w.y = cvt_pk_bf16(y[2], y[3]); o8[64 * j] = w; } } }
        }
        LDS_WAIT(); asm volatile("" ::: "memory");
        const int r = lane & 15, g = lane >> 4;
        const float rs = rstd_l[wave * 16 + r];
        const float* xrow = a.x1 + (size_t)(base + 16 * wave + r) * DM + 8 * g;
        const float* grow = a.norm_ffn + 8 * g;
        const LAS unsigned char* wl = lds + r * 2048; const int sw = r << 4, g16 = 16 * g;
        f32x4 acc0 = (f32x4){0.f, 0.f, 0.f, 0.f}, acc1 = (f32x4){0.f, 0.f, 0.f, 0.f};
#define P6_LD(S, off) f32x4 xa##S = *(const f32x4*)(xrow + (off)), xb##S = *(const f32x4*)(xrow + (off) + 4), ga##S = *(const f32x4*)(grow + (off)), gb##S = *(const f32x4*)(grow + (off) + 4); \
        bf16x8 h##S##0 = *(const LAS bf16x8*)(wl + (((off) * 2 + g16) ^ sw)), h##S##1 = *(const LAS bf16x8*)(wl + 32768 + (((off) * 2 + g16) ^ sw)), l##S##0 = *(const LAS bf16x8*)(wl + 65536 + (((off) * 2 + g16) ^ sw)), l##S##1 = *(const LAS bf16x8*)(wl + 98304 + (((off) * 2 + g16) ^ sw));
#define P6_RL(S, off) xa##S = *(const f32x4*)(xrow + (off)); xb##S = *(const f32x4*)(xrow + (off) + 4); ga##S = *(const f32x4*)(grow + (off)); gb##S = *(const f32x4*)(grow + (off) + 4); \
        h##S##0 = *(const LAS bf16x8*)(wl + (((off) * 2 + g16) ^ sw)); h##S##1 = *(const LAS bf16x8*)(wl + 32768 + (((off) * 2 + g16) ^ sw)); l##S##0 = *(const LAS bf16x8*)(wl + 65536 + (((off) * 2 + g16) ^ sw)); l##S##1 = *(const LAS bf16x8*)(wl + 98304 + (((off) * 2 + g16) ^ sw));
        P6_LD(0, 0) P6_LD(1, 32) P6_LD(2, 64) P6_LD(3, 96)
#define P6_MMA(XA, XB, GA, GB, H0, H1, L0, L1) { bf16x8 ahi, alo; p6_split8(XA, XB, GA, GB, rs, ahi, alo); \
            acc0 = __builtin_amdgcn_mfma_f32_16x16x32_bf16(ahi, H0, acc0, 0, 0, 0); acc0 = __builtin_amdgcn_mfma_f32_16x16x32_bf16(alo, H0, acc0, 0, 0, 0); acc0 = __builtin_amdgcn_mfma_f32_16x16x32_bf16(ahi, L0, acc0, 0, 0, 0); \
            acc1 = __builtin_amdgcn_mfma_f32_16x16x32_bf16(ahi, H1, acc1, 0, 0, 0); acc1 = __builtin_amdgcn_mfma_f32_16x16x32_bf16(alo, H1, acc1, 0, 0, 0); acc1 = __builtin_amdgcn_mfma_f32_16x16x32_bf16(ahi, L1, acc1, 0, 0, 0); }
#pragma unroll 1
        for (int ks = 0; ks < 32; ks += 4) {
            const int nx = (ks + 4 < 32) ? 32 * (ks + 4) : 0;
            P6_MMA(xa0, xb0, ga0, gb0, h00, h01, l00, l01) P6_RL(0, nx)
            P6_MMA(xa1, xb1, ga1, gb1, h10, h11, l10, l11) P6_RL(1, nx + 32)
            P6_MMA(xa2, xb2, ga2, gb2, h20, h21, l20, l21) P6_RL(2, nx + 64)
            P6_MMA(xa3, xb3, ga3, gb3, h30, h31, l30, l31) P6_RL(3, nx + 96)
        }
#undef P6_LD
#undef P6_RL
#undef P6_MMA
        { const float b0 = a.b_router[r], b1 = a.b_router[16 + r];
#pragma unroll
          for (int i = 0; i < 4; ++i) {
              float c0 = acc0[i] + b0, c1 = acc1[i] + b1;
              float tv[4]; int te[4];
#pragma unroll
              for (int k = 0; k < 4; ++k) {
                  float bv; int be; if (c1 > c0) { bv = c1; be = 16 + r; } else { bv = c0; be = r; }
#pragma unroll
                  for (int o = 1; o < 16; o <<= 1) { const float ov = __shfl_xor(bv, o); const int oe = __shfl_xor(be, o); if (ov > bv || (ov == bv && oe < be)) { bv = ov; be = oe; } }
                  tv[k] = bv; te[k] = be; if (be == r) c0 = -INFINITY; if (be == 16 + r) c1 = -INFINITY; }
              const float e1 = __expf(tv[1] - tv[0]), e2 = __expf(tv[2] - tv[0]), e3 = __expf(tv[3] - tv[0]); const float inv = 1.f / (1.f + e1 + e2 + e3);
              if (r < 4) { const int ee = r == 0 ? te[0] : r == 1 ? te[1] : r == 2 ? te[2] : te[3]; const float gg = (r == 0 ? 1.f : r == 1 ? e1 : r == 2 ? e2 : e3) * inv;
                  const unsigned lr = __hip_atomic_fetch_add(&lcnt[ee], 1u, __ATOMIC_RELAXED, __HIP_MEMORY_SCOPE_WORKGROUP); const int ri = 16 * wave + 4 * g + i; lsel[ri * 4 + r] = (unsigned)ee | (lr << 8); lgate[ri * 4 + r] = gg; }
          } }
        __syncthreads();
        if (tid < 32) lbase[tid] = __hip_atomic_fetch_add(a.cnt + 16 * tid, lcnt[tid], __ATOMIC_RELAXED, __HIP_MEMORY_SCOPE_AGENT);
        __syncthreads();
        for (int i = tid; i < rows_per * 4; i += 512) { const unsigned s = lsel[i]; const int e = s & 255; const unsigned pos = lbase[e] + (s >> 8); const int t = base + (i >> 2);
            a.toki[(size_t)t * 4 + (i & 3)] = (u32x2){(unsigned)e | (pos << 8), __float_as_uint(lgate[i])}; a.tokl[(size_t)e * T + pos] = t; }
        __syncthreads();
    }
}

__device__ __forceinline__ void p9_final(float* out, float* dst, const bf16* yexp, const u32x2* toki, const unsigned* cnt, const float* norm_final, LAS unsigned char* lds, int tid, int wave, int lane, int vcu, int G) {
    LAS int* pst = (LAS int*)lds;
    if (tid == 0) { int acc = 0; for (int e = 0; e < NEXP; ++e) { pst[e] = acc; acc += ((int)cnt[16 * e] + 255) / 256 * 256; } }
    __syncthreads();
    const int gw = vcu * 8 + wave, NGW = G * 8;
    for (int t0 = gw; t0 < T; t0 += 2 * NGW) {
        const int t1 = (t0 + NGW < T) ? t0 + NGW : t0;
        const f32x4* gr = (const f32x4*)norm_final + lane;
        u32x4 ta[2], tb[2];
#pragma unroll
        for (int u = 0; u < 2; ++u) { const u32x4* tp = (const u32x4*)(toki + (size_t)(u ? t1 : t0) * 4); ta[u] = tp[0]; tb[u] = tp[1]; }
        u32x2 yv[2][4][4]; f32x4 v[2][4];
#pragma unroll
        for (int u = 0; u < 2; ++u) { const int t = u ? t1 : t0; const unsigned ti[4] = {ta[u].x, ta[u].z, tb[u].x, tb[u].z};
#pragma unroll
            for (int k = 0; k < 4; ++k) { const int e = ti[k] & 255; const int pos = ti[k] >> 8; const u32x2* yr = (const u32x2*)(yexp + (size_t)(pst[e] + pos) * DM) + lane;
#pragma unroll
                for (int j = 0; j < 4; ++j) yv[u][k][j] = yr[64 * j]; }
            const f32x4* xr = (const f32x4*)(out + (size_t)t * DM) + lane;
#pragma unroll
            for (int j = 0; j < 4; ++j) v[u][j] = xr[64 * j]; }
#pragma unroll
        for (int u = 0; u < 2; ++u) { const int t = u ? t1 : t0; if (u == 1 && t1 == t0) break;
            const float tg[4] = {__uint_as_float(ta[u].y), __uint_as_float(ta[u].w), __uint_as_float(tb[u].y), __uint_as_float(tb[u].w)};
#pragma unroll
            for (int k = 0; k < 4; ++k) { const float g = tg[k];
#pragma unroll
                for (int j = 0; j < 4; ++j) { const u32x2 w = yv[u][k][j]; v[u][j][0] += g * bflo(w.x); v[u][j][1] += g * bfhi(w.x); v[u][j][2] += g * bflo(w.y); v[u][j][3] += g * bfhi(w.y); } }
            float s = 0.f;
#pragma unroll
            for (int j = 0; j < 4; ++j) s += (v[u][j][0] * v[u][j][0] + v[u][j][1] * v[u][j][1]) + (v[u][j][2] * v[u][j][2] + v[u][j][3] * v[u][j][3]);
            const float rstd = rsqrtf(wave_sum(s) * (1.f / DM) + EPS);
            f32x4* dr = (f32x4*)(dst + (size_t)t * DM) + lane;
#pragma unroll
            for (int j = 0; j < 4; ++j) { const f32x4 g = gr[64 * j]; dr[64 * j] = v[u][j] * rstd * g; } }
    }
}
#define HAVE_MIX 1
struct MixArgs { const bf16* PROJ; const bf16* VT; unsigned short* MASKQ; bf16* YA; bf16* YB; float* HU; float* HD; const float* hgrn_norm; const float* lb_logits; const float* rel_bias; };
__device__ const unsigned char T5BUCKET[129] = {0, 1, 2, 3, 4, 5, 6, 7, 8, 9, 10, 11, 12, 13, 14, 15, 16, 16, 16, 17, 17, 18, 18, 18, 19, 19, 19, 20, 20, 20, 20, 21, 21, 21, 21, 22, 22, 22, 22, 22, 23, 23, 23, 23, 23, 23, 24, 24, 24, 24, 24, 24, 25, 25, 25, 25, 25, 25, 25, 26, 26, 26, 26, 26, 26, 26, 26, 27, 27, 27, 27, 27, 27, 27, 27, 27, 27, 28, 28, 28, 28, 28, 28, 28, 28, 28, 28, 29, 29, 29, 29, 29, 29, 29, 29, 29, 29, 29, 29, 30, 30, 30, 30, 30, 30, 30, 30, 30, 30, 30, 30, 30, 30, 31, 31, 31, 31, 31, 31, 31, 31, 31, 31, 31, 31, 31, 31, 31, 31};
constexpr float LOG2E = 1.4426950408889634f;
__device__ __forceinline__ bf16x8 pack8(float a0, float a1, float a2, float a3, float a4, float a5, float a6, float a7) {
    u32x4 w; w.x = cvt_pk_bf16(a0, a1); w.y = cvt_pk_bf16(a2, a3); w.z = cvt_pk_bf16(a4, a5); w.w = cvt_pk_bf16(a6, a7); return __builtin_bit_cast(bf16x8, w);
}
__device__ __forceinline__ bf16x8 lo4(u32x2 v) { u32x4 w; w.x = v.x; w.y = v.y; w.z = 0u; w.w = 0u; return __builtin_bit_cast(bf16x8, w); }

__device__ __forceinline__ void pidx_unit(const MixArgs& m, LAS unsigned char* lds, int tid, int wave, int lane, int b, int qt) {
    LAS unsigned* hist = (LAS unsigned*)lds;
    LAS unsigned* s_pfx = (LAS unsigned*)(lds + 16512);
    LAS unsigned* s_k2 = (LAS unsigned*)(lds + 16640);
    LAS unsigned* s_krem = (LAS unsigned*)(lds + 16768);
    LAS unsigned* kbq = (LAS unsigned*)(lds + 16896);
    LAS unsigned* s_unres = (LAS unsigned*)(lds + 25088);
    const int c = lane & 15, g = lane >> 4;
    const size_t rowq = (size_t)b * SEQ + (size_t)qt * 16;
    const bf16* PROJ = m.PROJ;
    for (int i = tid; i < 16 * 257; i += 512) hist[i] = 0u;
    for (int i = tid; i < 16 * 128; i += 512) kbq[i] = 0u;
    if (tid < 16) { s_pfx[tid] = 0u; s_k2[tid] = 0u; const int nv = qt * 16 + tid + 1; s_krem[tid] = (unsigned)(nv < 256 ? nv : 256); if (tid < 6) s_unres[tid] = 0u; }
    __syncthreads();
    const float WS = 0.35355339059327373f * 0.17677669529663687f * 0.5f;
    bf16x8 qf[8];
#pragma unroll
    for (int h = 0; h < 8; ++h) qf[h] = *(const bf16x8*)(PROJ + (rowq + c) * NPJ + C_IQ + h * 32 + 8 * g);
    bf16x8 ql; float wq[8];
    { const u32x4 wr = *(const u32x4*)(PROJ + (rowq + c) * NPJ + C_IW);
      wq[0] = bflo(wr.x) * WS; wq[1] = bfhi(wr.x) * WS; wq[2] = bflo(wr.y) * WS; wq[3] = bfhi(wr.y) * WS; wq[4] = bflo(wr.z) * WS; wq[5] = bfhi(wr.z) * WS; wq[6] = bflo(wr.w) * WS; wq[7] = bfhi(wr.w) * WS;
      float a[8];
#pragma unroll
      for (int j = 0; j < 8; ++j) { a[j] = 0.f;
#pragma unroll
          for (int h = 0; h < 8; ++h) a[j] += wq[h] * bf2f((unsigned short)qf[h][j]); }
      ql = pack8(a[0], a[1], a[2], a[3], a[4], a[5], a[6], a[7]); }
    const int ngrp = qt / 4 + 1, tq = qt * 16 + c;
    unsigned sc[8][4][4];
    const bf16* kbase = PROJ + ((size_t)b * SEQ + c) * NPJ + C_IK + 8 * g;
    bf16x8 kn[4];
#pragma unroll
    for (int j = 0; j < 4; ++j) kn[j] = (wave < ngrp) ? *(const bf16x8*)(kbase + (size_t)((wave * 4 + j) * 16) * NPJ) : (bf16x8){0, 0, 0, 0, 0, 0, 0, 0};
#pragma unroll
    for (int slot = 0; slot < 8; ++slot) {
        const int g64 = slot * 8 + wave;
        bf16x8 kc[4];
#pragma unroll
        for (int j = 0; j < 4; ++j) kc[j] = kn[j];
        if (slot < 7 && g64 + 8 < ngrp) {
#pragma unroll
            for (int j = 0; j < 4; ++j) kn[j] = *(const bf16x8*)(kbase + (size_t)(((g64 + 8) * 4 + j) * 16) * NPJ);
        }
        if (g64 < ngrp) {
#pragma unroll
            for (int j = 0; j < 4; ++j) { const int key0 = (g64 * 4 + j) * 16;
                const bf16x8 kf = kc[j];
                f32x4 acc = __builtin_amdgcn_mfma_f32_16x16x32_bf16(kf, ql, (f32x4){0.f, 0.f, 0.f, 0.f}, 0, 0, 0);
#pragma unroll
                for (int h = 0; h < 8; ++h) { const f32x4 d = __builtin_amdgcn_mfma_f32_16x16x32_bf16(kf, qf[h], (f32x4){0.f, 0.f, 0.f, 0.f}, 0, 0, 0);
#pragma unroll
                    for (int i = 0; i < 4; ++i) acc[i] += wq[h] * __builtin_fabsf(d[i]); }
#pragma unroll
                for (int i = 0; i < 4; ++i) { const bool valid = key0 + 4 * g + i <= tq; const unsigned bits = __float_as_uint(acc[i]); const unsigned u = bits ^ ((unsigned)((int)bits >> 31) | 0x80000000u); sc[slot][j][i] = valid ? u : 0u;
                    if (valid) (void)__hip_atomic_fetch_add(&hist[c * 257 + (u >> 24)], 1u, __ATOMIC_RELAXED, __HIP_MEMORY_SCOPE_WORKGROUP); } }
        } else {
#pragma unroll
            for (int j = 0; j < 4; ++j)
#pragma unroll
                for (int i = 0; i < 4; ++i) sc[slot][j][i] = 0u;
        }
    }
    __syncthreads();
    bool finished = false; int fb = 0;
#pragma unroll
    for (int p = 0; p < 6; ++p) {
        if (finished) continue;
        const int rb = p & 1, wb = rb ^ 1;
        const unsigned pf = s_pfx[rb * 16 + c], k2p = s_k2[rb * 16 + c];
#pragma unroll
        for (int slot = 0; slot < 8; ++slot) {
            const int g64 = slot * 8 + wave;
            if (g64 < ngrp) {
#pragma unroll
                for (int j = 0; j < 4; ++j)
#pragma unroll
                    for (int i = 0; i < 4; ++i) { const unsigned u = sc[slot][j][i]; const unsigned key2 = 4095u - (unsigned)((g64 * 4 + j) * 16 + 4 * g + i);
                        bool part; unsigned bin;
                        if (p == 0) { part = false; bin = 0u; }
                        else if (p < 4) { const int sh = 24 - 8 * p; part = (u != 0u) && ((u >> (sh + 8)) == (pf >> (sh + 8))); bin = (u >> sh) & 255u; }
                        else if (p == 4) { part = (u != 0u) && (u == pf); bin = key2 >> 4; }
                        else { part = (u != 0u) && (u == pf) && ((key2 >> 4) == (k2p >> 4)); bin = key2 & 15u; }
                        if (part) (void)__hip_atomic_fetch_add(&hist[c * 257 + bin], 1u, __ATOMIC_RELAXED, __HIP_MEMORY_SCOPE_WORKGROUP); }
            }
        }
        __syncthreads();
        { const int qq = tid >> 5, jj = tid & 31; const unsigned krem = s_krem[rb * 16 + qq];
          unsigned h8[8]; unsigned csum = 0u;
#pragma unroll
          for (int k = 0; k < 8; ++k) { h8[k] = hist[qq * 257 + 255 - 8 * jj - k]; csum += h8[k]; }
          unsigned incl = csum;
#pragma unroll
          for (int o = 1; o < 32; o <<= 1) { const unsigned v = __shfl_up(incl, o, 32); if (jj >= o) incl += v; }
          const unsigned excl = incl - csum;
          if (excl < krem && krem <= incl) { unsigned run = excl, bin = 0u, newk = 0u, hsel = 0u; bool done = false;
#pragma unroll
              for (int k = 0; k < 8; ++k) { if (!done) { if (run + h8[k] >= krem) { bin = (unsigned)(255 - 8 * jj - k); newk = krem - run; hsel = h8[k]; done = true; } else run += h8[k]; } }
              if (hsel != newk) s_unres[p] = 1u;
              const unsigned op = s_pfx[rb * 16 + qq], ok2 = s_k2[rb * 16 + qq];
              if (p < 4) { s_pfx[wb * 16 + qq] = op | (bin << (24 - 8 * (p < 4 ? p : 0))); s_k2[wb * 16 + qq] = 0u; }
              else if (p == 4) { s_pfx[wb * 16 + qq] = op; s_k2[wb * 16 + qq] = bin << 4; }
              else { s_pfx[wb * 16 + qq] = op; s_k2[wb * 16 + qq] = ok2 | bin; }
              s_krem[wb * 16 + qq] = newk; }
#pragma unroll
          for (int k = 0; k < 8; ++k) hist[qq * 257 + 255 - 8 * jj - k] = 0u;
        }
        __syncthreads();
        fb = wb; finished = (s_unres[p] == 0u);
    }
    { const unsigned thr = s_pfx[fb * 16 + c], tk2 = s_k2[fb * 16 + c];
#pragma unroll
      for (int slot = 0; slot < 8; ++slot) {
          const int g64 = slot * 8 + wave;
          if (g64 < ngrp) {
#pragma unroll
              for (int j = 0; j < 4; ++j)
#pragma unroll
                  for (int i = 0; i < 4; ++i) { const unsigned u = sc[slot][j][i]; const int key = (g64 * 4 + j) * 16 + 4 * g + i; const unsigned key2 = 4095u - (unsigned)key;
                      const bool sel = (u > thr) || (u == thr && u != 0u && key2 >= tk2);
                      if (sel) (void)__hip_atomic_fetch_or(&kbq[c * 128 + (key >> 5)], 1u << (key & 31), __ATOMIC_RELAXED, __HIP_MEMORY_SCOPE_WORKGROUP); }
          }
      }
    }
    __syncthreads();
    for (int idx = tid; idx < 16 * ngrp; idx += 512) { const int qq = idx & 15, gg = idx >> 4;
        *(u32x2*)(m.MASKQ + (rowq + qq) * 256 + 4 * gg) = *(const LAS u32x2*)(kbq + qq * 128 + 2 * gg); }
    __syncthreads();
}

__device__ __forceinline__ void attn_unit(const MixArgs& m, LAS unsigned char* lds, int tid, int wave, int lane, int b, int h, int qb) {
    LAS bf16* Ks = (LAS bf16*)lds;
    LAS bf16* Vs = (LAS bf16*)(lds + 18432);
    LAS float* btab = (LAS float*)(lds + 36864);
    const int r32 = lane & 31, hi = lane >> 5;
    if (tid < 129) btab[tid] = m.rel_bias[(int)T5BUCKET[tid] * 8 + h] * LOG2E;
    const float bfar = m.rel_bias[31 * 8 + h] * LOG2E;
    const float C2 = 0.125f * LOG2E;
    const int q0w = qb * 256 + 32 * wave;
    const size_t rowq = (size_t)b * SEQ + q0w + r32;
    bf16x8 qf[4];
#pragma unroll
    for (int ds = 0; ds < 4; ++ds) qf[ds] = *(const bf16x8*)(m.PROJ + rowq * NPJ + C_AQ + h * 64 + 16 * ds + 8 * hi);
    const int NT = 4 * qb + 4, tw = 4 * qb + (wave >> 1);
    const int srow = tid >> 3, sch = tid & 7;
    const bf16* kptr = m.PROJ + ((size_t)b * SEQ + srow) * NPJ + C_AK + h * 64 + 8 * sch;
    const bf16* vptr = m.VT + (size_t)(h * 64 + srow) * T + (size_t)b * SEQ + 8 * sch;
    u32x4 kr = *(const u32x4*)kptr, vr = *(const u32x4*)vptr;
    *(LAS u32x4*)(Ks + srow * 72 + 8 * sch) = kr; *(LAS u32x4*)(Vs + srow * 72 + 8 * sch) = vr;
    __syncthreads();
    float m_run = -INFINITY, l_run = 0.f; f32x16 o[2];
#pragma unroll
    for (int r = 0; r < 16; ++r) { o[0][r] = 0.f; o[1][r] = 0.f; }
    const unsigned long long* mrow = (const unsigned long long*)(m.MASKQ + rowq * 256);
    for (int t = 0; t < NT; ++t) {
        const int buf = t & 1;
        if (t + 1 < NT) { kr = *(const u32x4*)(kptr + (size_t)(t + 1) * 64 * NPJ); vr = *(const u32x4*)(vptr + (t + 1) * 64); }
        if (t <= tw) {
            const unsigned long long mw = mrow[t] >> (4 * hi);
            const unsigned mlo = (unsigned)mw, mhi = (unsigned)(mw >> 32);
            f32x16 p[2];
#pragma unroll
            for (int hh = 0; hh < 2; ++hh) {
#pragma unroll
                for (int r = 0; r < 16; ++r) p[hh][r] = 0.f;
#pragma unroll
                for (int ds = 0; ds < 4; ++ds) { const bf16x8 kf = *(const LAS bf16x8*)(Ks + buf * 4608 + (32 * hh + r32) * 72 + 16 * ds + 8 * hi);
                    p[hh] = __builtin_amdgcn_mfma_f32_32x32x16_bf16(kf, qf[ds], p[hh], 0, 0, 0); }
            }
            const bool near = (q0w - (64 * t + 63)) < 128;
            float mx = -INFINITY;
#pragma unroll
            for (int hh = 0; hh < 2; ++hh) { const int dbase = q0w + r32 - (64 * t + 32 * hh + 4 * hi); const unsigned mword = hh ? mhi : mlo;
#pragma unroll
                for (int r = 0; r < 16; ++r) { const int cpos = (r & 3) + 8 * (r >> 2);
                    float bias = bfar;
                    if (near) { int dd = dbase - cpos; dd = dd < 0 ? 0 : (dd > 128 ? 128 : dd); bias = btab[dd]; }
                    float s = p[hh][r] * C2 + bias; s = ((mword >> cpos) & 1u) ? s : -INFINITY; p[hh][r] = s; mx = fmaxf(mx, s); } }
            mx = fmaxf(mx, __shfl_xor(mx, 32));
            const float m_new = fmaxf(m_run, mx); const float msafe = (m_new == -INFINITY) ? 0.f : m_new;
            const float alpha = __builtin_amdgcn_exp2f(m_run - msafe); m_run = m_new;
            float rs = 0.f;
#pragma unroll
            for (int hh = 0; hh < 2; ++hh)
#pragma unroll
                for (int r = 0; r < 16; ++r) { const float e = __builtin_amdgcn_exp2f(p[hh][r] - msafe); p[hh][r] = e; rs += e; }
            l_run = l_run * alpha + rs;
#pragma unroll
            for (int r = 0; r < 16; ++r) { o[0][r] *= alpha; o[1][r] *= alpha; }
#pragma unroll
            for (int ks = 0; ks < 4; ++ks) { const int hh = ks >> 1, s2 = ks & 1;
                const bf16x8 pb = pack8(p[hh][8 * s2 + 0], p[hh][8 * s2 + 1], p[hh][8 * s2 + 2], p[hh][8 * s2 + 3], p[hh][8 * s2 + 4], p[hh][8 * s2 + 5], p[hh][8 * s2 + 6], p[hh][8 * s2 + 7]);
#pragma unroll
                for (int dh = 0; dh < 2; ++dh) { const LAS bf16* vp = Vs + buf * 4608 + (32 * dh + r32) * 72 + 32 * hh + 16 * s2 + 4 * hi;
                    const u32x2 v0 = *(const LAS u32x2*)vp, v1 = *(const LAS u32x2*)(vp + 8);
                    u32x4 vw; vw.x = v0.x; vw.y = v0.y; vw.z = v1.x; vw.w = v1.y;
                    o[dh] = __builtin_amdgcn_mfma_f32_32x32x16_bf16(__builtin_bit_cast(bf16x8, vw), pb, o[dh], 0, 0, 0); } }
        }
        if (t + 1 < NT) { *(LAS u32x4*)(Ks + (buf ^ 1) * 4608 + srow * 72 + 8 * sch) = kr; *(LAS u32x4*)(Vs + (buf ^ 1) * 4608 + srow * 72 + 8 * sch) = vr; }
        __syncthreads();
    }
    const float lt = l_run + __shfl_xor(l_run, 32); const float inv = 1.0f / lt;
    bf16* orow = m.YA + rowq * 1024 + h * 64;
#pragma unroll
    for (int dh = 0; dh < 2; ++dh)
#pragma unroll
        for (int a = 0; a < 4; ++a) { u32x2 w; w.x = cvt_pk_bf16(o[dh][4 * a] * inv, o[dh][4 * a + 1] * inv); w.y = cvt_pk_bf16(o[dh][4 * a + 2] * inv, o[dh][4 * a + 3] * inv);
            *(u32x2*)(orow + 32 * dh + 8 * a + 4 * hi) = w; }
    __syncthreads();
}

template <bool OUT> __device__ __forceinline__ void hgrn_unit(const MixArgs& m, LAS unsigned char* lds, int tid, int wave, int lane, int b, int h, int c) {
    LAS bf16* QT = (LAS bf16*)lds;
    LAS bf16* KH = (LAS bf16*)(lds + 4352);
    LAS bf16* KT = (LAS bf16*)(lds + 8704);
    LAS bf16* VTL = (LAS bf16*)(lds + 12800);
    LAS float* DEC = (LAS float*)(lds + 16896);
    LAS float* PART = (LAS float*)(lds + 17408);
    LAS float* OBUF = (LAS float*)(lds + 19456);
    const bf16* PROJ = m.PROJ;
    const int d = tid & 127, tq = tid >> 7;
    const int c16 = lane & 15, g = lane >> 4;
    const int bh = b * 4 + h;
    const float lbv = sigmoidf_(m.lb_logits[h * 128 + d] - m.lb_logits[512 + h * 128 + d]);
    float Btot = 1.f;
    f32x4 st[8];
#pragma unroll
    for (int dt = 0; dt < 8; ++dt) st[dt] = (f32x4){0.f, 0.f, 0.f, 0.f};
    if (OUT) {
        const int e = 16 * wave + c16;
        for (int j = 0; j < c; ++j) { const float* U = m.HU + (size_t)(bh * 16 + j) * 16384; const float* Dj = m.HD + (size_t)(bh * 16 + j) * 128;
#pragma unroll
            for (int dt = 0; dt < 8; ++dt) { const f32x4 dv = *(const f32x4*)(Dj + 16 * dt + 4 * g);
#pragma unroll
                for (int i = 0; i < 4; ++i) st[dt][i] = dv[i] * st[dt][i] + U[(size_t)(16 * dt + 4 * g + i) * 128 + e]; } }
    }
    unsigned short rf[4], rq[4], rv[4], nf[4], nq[4], nv[4];
    { const size_t row0 = (size_t)b * SEQ + (size_t)c * 256;
#pragma unroll
      for (int k = 0; k < 4; ++k) { const bf16* pr = PROJ + (row0 + 4 * tq + k) * NPJ + h * 128 + d; rf[k] = pr[C_BF]; rq[k] = pr[C_BQ]; rv[k] = pr[C_BI]; } }
    for (int s16 = 0; s16 < 16; ++s16) {
        const size_t row0 = (size_t)b * SEQ + (size_t)c * 256 + s16 * 16;
        if (s16 < 15) {
#pragma unroll
            for (int k = 0; k < 4; ++k) { const bf16* pr = PROJ + (row0 + 16 + 4 * tq + k) * NPJ + h * 128 + d; nf[k] = pr[C_BF]; nq[k] = pr[C_BQ]; nv[k] = pr[C_BI]; } }
        unsigned short pg0[2], pg1[2];
        if (OUT) {
#pragma unroll
            for (int q = 0; q < 2; ++q) { const bf16* pg = PROJ + (row0 + 2 * wave + q) * NPJ + C_BG + h * 128; pg0[q] = pg[lane]; pg1[q] = pg[64 + lane]; } }
        float kk[4], qs[4], cum[4]; unsigned short vraw[4];
#pragma unroll
        for (int k = 0; k < 4; ++k) {
            const float fr = bf2f(rf[k]), qr = bf2f(rq[k]); vraw[k] = rv[k];
            const float f = lbv + (1.f - lbv) * sigmoidf_(fr); cum[k] = (k == 0) ? f : cum[k - 1] * f; kk[k] = 1.f - f; qs[k] = qr * sigmoidf_(qr) * 0.08838834764831845f; }
        PART[tq * 128 + d] = cum[3];
        { u32x2 w; w.x = (unsigned)vraw[0] | ((unsigned)vraw[1] << 16); w.y = (unsigned)vraw[2] | ((unsigned)vraw[3] << 16); *(LAS u32x2*)(VTL + d * 16 + 4 * tq) = w; }
        __syncthreads();
        float off = 1.f, tot = 1.f;
#pragma unroll
        for (int q = 0; q < 4; ++q) { const float pv = PART[q * 128 + d]; tot *= pv; if (q < tq) off *= pv; }
        float kt4[4];
#pragma unroll
        for (int k = 0; k < 4; ++k) { const float Pt = off * cum[k]; const float rP = __builtin_amdgcn_rcpf(Pt); const int tt = 4 * tq + k;
            QT[tt * 136 + d] = (bf16)(cvt_pk_bf16(qs[k] * Pt, 0.f) & 0xffffu);
            KH[tt * 136 + d] = (bf16)(cvt_pk_bf16(kk[k] * rP, 0.f) & 0xffffu);
            kt4[k] = kk[k] * (tot * rP); }
        { u32x2 w; w.x = cvt_pk_bf16(kt4[0], kt4[1]); w.y = cvt_pk_bf16(kt4[2], kt4[3]); *(LAS u32x2*)(KT + d * 16 + 4 * tq) = w; }
        if (tq == 0) { DEC[d] = tot; Btot *= tot; }
        __syncthreads();
        const bf16x8 bv = lo4(*(const LAS u32x2*)(VTL + (16 * wave + c16) * 16 + 4 * g));
        if (OUT) {
            f32x4 acc = (f32x4){0.f, 0.f, 0.f, 0.f}, aT = (f32x4){0.f, 0.f, 0.f, 0.f};
#pragma unroll
            for (int ks = 0; ks < 4; ++ks) {
                const u32x2 a0 = *(const LAS u32x2*)(QT + c16 * 136 + 32 * ks + 4 * g), a1 = *(const LAS u32x2*)(QT + c16 * 136 + 32 * ks + 16 + 4 * g);
                u32x4 aw; aw.x = a0.x; aw.y = a0.y; aw.z = a1.x; aw.w = a1.y;
                const bf16x8 sb = pack8(st[2 * ks][0], st[2 * ks][1], st[2 * ks][2], st[2 * ks][3], st[2 * ks + 1][0], st[2 * ks + 1][1], st[2 * ks + 1][2], st[2 * ks + 1][3]);
                acc = __builtin_amdgcn_mfma_f32_16x16x32_bf16(__builtin_bit_cast(bf16x8, aw), sb, acc, 0, 0, 0);
                const bf16x8 kh = *(const LAS bf16x8*)(KH + c16 * 136 + 32 * ks + 8 * g), qn = *(const LAS bf16x8*)(QT + c16 * 136 + 32 * ks + 8 * g);
                aT = __builtin_amdgcn_mfma_f32_16x16x32_bf16(kh, qn, aT, 0, 0, 0);
            }
#pragma unroll
            for (int i = 0; i < 4; ++i) if (4 * g + i > c16) aT[i] = 0.f;
            const bf16x8 aa = pack8(aT[0], aT[1], aT[2], aT[3], 0.f, 0.f, 0.f, 0.f);
            acc = __builtin_amdgcn_mfma_f32_16x16x32_bf16(aa, bv, acc, 0, 0, 0);
#pragma unroll
            for (int i = 0; i < 4; ++i) OBUF[(4 * g + i) * 132 + 16 * wave + c16] = acc[i];
        }
#pragma unroll
        for (int dt = 0; dt < 8; ++dt) { const bf16x8 ka = lo4(*(const LAS u32x2*)(KT + (16 * dt + c16) * 16 + 4 * g)); const f32x4 dv = *(const LAS f32x4*)(DEC + 16 * dt + 4 * g);
            st[dt] = __builtin_amdgcn_mfma_f32_16x16x32_bf16(ka, bv, st[dt] * dv, 0, 0, 0); }
        __syncthreads();
        if (OUT) {
#pragma unroll
            for (int q = 0; q < 2; ++q) { const int t = 2 * wave + q; const float o0 = OBUF[t * 132 + lane], o1 = OBUF[t * 132 + 64 + lane];
                const float rstd = rsqrtf(wave_sum(o0 * o0 + o1 * o1) * (1.f / 128.f) + EPS);
                const float g0 = bf2f(pg0[q]), g1 = bf2f(pg1[q]);
                const float y0 = o0 * rstd * m.hgrn_norm[h * 128 + lane] * g0 * sigmoidf_(g0), y1 = o1 * rstd * m.hgrn_norm[h * 128 + 64 + lane] * g1 * sigmoidf_(g1);
                bf16* yo = m.YB + (row0 + t) * 1024 + h * 128;
                yo[lane] = (bf16)(cvt_pk_bf16(y0, 0.f) & 0xffffu); yo[64 + lane] = (bf16)(cvt_pk_bf16(y1, 0.f) & 0xffffu); }
        }
#pragma unroll
        for (int k = 0; k < 4; ++k) { rf[k] = nf[k]; rq[k] = nq[k]; rv[k] = nv[k]; }
    }
    if (!OUT) {
        const int e = 16 * wave + c16; float* U = m.HU + (size_t)(bh * 16 + c) * 16384;
#pragma unroll
        for (int dt = 0; dt < 8; ++dt)
#pragma unroll
            for (int i = 0; i < 4; ++i) U[(size_t)(16 * dt + 4 * g + i) * 128 + e] = st[dt][i];
        if (tq == 0) m.HD[(size_t)(bh * 16 + c) * 128 + d] = Btot;
    }
    __syncthreads();
}

__device__ __forceinline__ MixArgs make_mix(const Args& args) {
    unsigned char* ws = args.ws;
    return MixArgs{(const bf16*)(ws + WS_PROJ), (const bf16*)(ws + WS_VT), (unsigned short*)(ws + WS_MASK), (bf16*)(ws + WS_YA), (bf16*)(ws + WS_YA) + 512, (float*)(ws + WS_HU), (float*)(ws + WS_HD), args.in[8], args.in[9], args.in[10]};
}
__device__ __forceinline__ void p2_phase(const Args& args, LAS unsigned char* lds, int tid, int wave, int lane, int bx, int G) {
    const MixArgs m = make_mix(args);
    if (args.sub & 1) {
#define PIDX_ROUND(r) { const int k = ((r) & 1) ? (G - 1 - bx) : bx; const int u = (r) * G + k; if (u < 2048) pidx_unit(m, lds, tid, wave, lane, u & 7, 255 - (u >> 3)); }
    PIDX_ROUND(0) PIDX_ROUND(1) PIDX_ROUND(2) PIDX_ROUND(3) PIDX_ROUND(4) PIDX_ROUND(5) PIDX_ROUND(6) PIDX_ROUND(7)
#undef PIDX_ROUND
    }
    if (args.sub & 2)
    for (int u = bx; u < 480; u += G) { const int bh = u / 15, c = u % 15; hgrn_unit<false>(m, lds, tid, wave, lane, bh >> 2, bh & 3, c); }
}
__device__ __forceinline__ void p3_phase(const Args& args, LAS unsigned char* lds, int tid, int wave, int lane, int bx, int G) {
    const MixArgs m = make_mix(args);
    int round = 0;
    if (args.sub & 1)
    for (int base = 0; base < 1024; base += G, ++round) { const int k = (round & 1) ? (G - 1 - bx) : bx; const int u = base + k; if (u < 1024) { const int qb = 15 - (u >> 6), bhh = u & 63; attn_unit(m, lds, tid, wave, lane, bhh >> 3, bhh & 7, qb); } }
    if (args.sub & 2)
    for (int u = bx; u < 512; u += G) { const int bh = u >> 4, c = u & 15; hgrn_unit<true>(m, lds, tid, wave, lane, bh >> 2, bh & 3, 15 - c); }
}

__global__ void __launch_bounds__(512, 2) mk_fwd(Args args) {
    extern __shared__ __attribute__((aligned(16))) unsigned char lds_raw[];
    LAS unsigned char* lds = (LAS unsigned char*)lds_raw;
    volatile LAS unsigned* MISC = (volatile LAS unsigned*)(lds + MISC_OFF);
    const int tid = threadIdx.x, lane = tid & 63, wave = __builtin_amdgcn_readfirstlane(tid >> 6);
    const int G = gridDim.x; const int bx = blockIdx.x; const int vcu = (G % 8 == 0) ? (bx % 8) * (G / 8) + bx / 8 : bx;
    unsigned char* ws = args.ws;
    unsigned* ctl = (unsigned*)(ws + WS_CTL);
    for (int u = tid; u < (LDS_BYTES - RING_BYTES) / 4; u += 512) ((LAS unsigned*)(lds + RING_BYTES))[u] = 0u;
    __syncthreads();
    if (tid == 0) { const unsigned xcc = xb_xcc_id(); MISC[12] = xcc; MISC[13] = __hip_atomic_fetch_add(ctl + CW_TICK + 64 * xcc, 1u, __ATOMIC_RELAXED, __HIP_MEMORY_SCOPE_AGENT); }
    XcdBarrier bar; bar.bar = ctl + CW_BAR; bar.x = 0; bar.st = nullptr;
    if (MK_N_LAUNCHES == 1) bar = xcd_barrier_post(ctl + CW_BAR, MISC + 8);
    const int lo = args.ph_lo, hi = args.ph_hi;
#define IN(k) (lo <= (k) && (k) < hi)
#ifdef DBG_TPHASE
#define STAMP(k) do { if (bx == 0 && tid == 0) ((unsigned long long*)(ctl + 2048))[(k)] = __builtin_amdgcn_s_memrealtime(); } while (0)
#else
#define STAMP(k) do { } while (0)
#endif
#define SEAM(k) do { if (IN(k) && IN((k) + 1)) xcd_barrier(bar); STAMP((k) + 1); } while (0)
    STAMP(0);

    bf16* const WIN = (bf16*)(ws + WS_WIN); bf16* const WV = (bf16*)(ws + WS_WV); bf16* const WUA = (bf16*)(ws + WS_WUA); bf16* const WUB = (bf16*)(ws + WS_WUB);
#ifdef WEIGHTS_IN_GLOBALS
    bf16* const WO = (bf16*)(ws + WS_WO); bf16* const WGU = (bf16*)g_wgu8; bf16* const WDN = (bf16*)g_wdn8;
#else
    bf16* const WO = (bf16*)(ws + WS_WO); bf16* const WGU = (bf16*)(ws + WS_WGU); bf16* const WDN = (bf16*)(ws + WS_WDN);
#endif
    bf16* const XN = (bf16*)(ws + WS_XN); bf16* const PROJ = (bf16*)(ws + WS_PROJ); bf16* const VT = (bf16*)(ws + WS_VT);
    bf16* const YA = (bf16*)(ws + WS_YA); bf16* const YB = (bf16*)(ws + WS_YB); bf16* const MRG = (bf16*)(ws + WS_MRG);
    bf16* const ACT = (bf16*)(ws + WS_ACT); bf16* const YEXP = (bf16*)(ws + WS_YEXP);
    int* const TOKL = (int*)(ws + WS_TOKL); u32x2* const TOKI = (u32x2*)(ws + WS_TOKI);
    unsigned* const CNT = ctl + CW_CNT;

    if (IN(0)) {
        P0Args a{args.in[0], args.in[1], args.in[2], args.in[3], args.in[4], args.in[5], args.in[13], args.in[15], args.in[11], ws, (unsigned char*)WGU, (unsigned char*)WDN};
        p0_prologue(a, lds, wave, lane, vcu, G);
    }
    SEAM(0);
    if (IN(1)) {
        { pg8::StaticSched S; S.init(XN, WIN, T, NPJ, DM, G, bx); pg8::EpiBf16 E{PROJ, NPJ, nullptr, 0, 1.f}; pg8::gemm_phase(lds, DM, S, E); }
        { pg8::StaticSched S; S.init(WV, XN, 512, T, DM, G, bx); pg8::EpiBf16 E{VT, T, nullptr, 0, 1.f}; pg8::gemm_phase(lds, DM, S, E); }
    }
    SEAM(1);
    if (IN(2)) {
#ifdef HAVE_MIX
        p2_phase(args, lds, tid, wave, lane, bx, G);
#endif
    }
    SEAM(2);
    if (IN(3)) {
#ifdef HAVE_MIX
        p3_phase(args, lds, tid, wave, lane, bx, G);
#endif
    }
    SEAM(3);
#ifndef DBG_NOMIX
    if (IN(4)) {
        { pg8::StaticSched S; S.init(YA, WUA, T, DM, DM, G, bx); pg8::EpiMerge2 E{PROJ + C_GA, PROJ + C_GB, MRG}; pg8::gemm_phase(lds, DM, S, E); }
    }
#ifndef DBG_NOMIX
    SEAM(4);
#endif
    if (IN(5)) {
        pg8::StaticSched S; S.init(MRG, WO, T, DM, DM, G, bx); pg8::EpiOutRes E{args.in[0], args.out}; pg8::gemm_phase(lds, DM, S, E);
    }
#else
    SEAM(4);
    if (IN(5)) { for (int m = vcu * 8 + wave; m < T; m += G * 8) { const f32x4* xr = (const f32x4*)(args.in[0] + (size_t)m * DM) + lane; f32x4* orow = (f32x4*)(args.out + (size_t)m * DM) + lane;
        for (int j = 0; j < 4; ++j) orow[64 * j] = xr[64 * j]; } }
#endif
    SEAM(5);
    if (IN(6)) {
        P6Args a{args.out, args.in[6], (const bf16*)(ws + WS_WRH), (const bf16*)(ws + WS_WRL), args.in[12], (unsigned char*)XN, CNT, TOKL, TOKI};
        p6_router(a, lds, tid, wave, lane, vcu, G);
    }
    SEAM(6);
    if (IN(7) || IN(8)) {
        LAS int* tstart = (LAS int*)(lds + RING_BYTES + 16);
        if (tid == 0) { int acc = 0; for (int e = 0; e < NEXP; ++e) { tstart[e] = acc; acc += ((int)__hip_atomic_load(CNT + 16 * e, __ATOMIC_RELAXED, __HIP_MEMORY_SCOPE_AGENT) + 255) / 256; } tstart[NEXP] = acc;
            bool ok = (G % 8 == 0); for (int j = 0; j < 8; ++j) ok = ok && (__hip_atomic_load(ctl + CW_TICK + 64 * j, __ATOMIC_RELAXED, __HIP_MEMORY_SCOPE_AGENT) == (unsigned)(G / 8));
            MISC[14] = ok ? MISC[12] * (unsigned)(G / 8) + MISC[13] : (unsigned)bx; }
        __syncthreads();
        const int vb = (int)MISC[14];
#if MOE_F8
#ifdef F8_PROBE
        if (IN(7) && (args.sub & 8)) { f8g::Sched<true> S{(const unsigned char*)XN, (const unsigned char*)WGU, TOKL, (const int*)CNT, tstart, DM, 8, 2 * DFF, G,
#ifdef F8_PROBE_SAME
            vb & ~31
#else
            vb
#endif
            }; f8g::EpiSwiGLU8 E{args.in[14], (unsigned char*)ACT}; f8g::gemm<f8g::EpiSwiGLU8, f8g::Sched<true>, F8_PROBE>(lds, DM, S, E); } else
#endif
        if (IN(7)) { f8g::Sched<true> S{(const unsigned char*)XN, (const unsigned char*)WGU, TOKL, (const int*)CNT, tstart, DM, 8, 2 * DFF, G, vb}; f8g::EpiSwiGLU8 E{args.in[14], (unsigned char*)ACT}; f8g::gemm(lds, DM, S, E); }
        SEAM(7);
        if (IN(8)) { f8g::Sched<false> S{(const unsigned char*)ACT, (const unsigned char*)WDN, TOKL, (const int*)CNT, tstart, DFF, 4, DM, G, vb}; f8g::EpiDown8 E{args.in[16], YEXP}; f8g::gemm(lds, DFF, S, E); }
#else
        if (IN(7)) {
            constexpr int EB = MOE_F8 ? 1 : 2;
            pg8::MoeSched<true> S{(const unsigned char*)XN, (const unsigned char*)WGU, TOKL, (const int*)CNT, tstart, DM * EB, 8, 2 * DFF, G, bx};
            pg8::EpiSwiGLU E{args.in[14], (unsigned char*)ACT, MOE_F8 ? 1.f / 32.f : 1.f}; pg8::gemm_phase<pg8::EpiSwiGLU, pg8::MoeSched<true>, MOE_F8 != 0>(lds, DM, S, E);
        }
        SEAM(7);
        if (IN(8)) {
            constexpr int EB = MOE_F8 ? 1 : 2;
            pg8::MoeSched<false> S{(const unsigned char*)ACT, (const unsigned char*)WDN, TOKL, (const int*)CNT, tstart, DFF * EB, 4, DM, G, bx};
            pg8::EpiBf16 E{YEXP, DM, args.in[16], DM, MOE_F8 ? 1.f / 32.f : 1.f}; pg8::gemm_phase<pg8::EpiBf16, pg8::MoeSched<false>, MOE_F8 != 0>(lds, DFF, S, E);
        }
#endif
    }
    SEAM(8);
    if (IN(9)) p9_final(args.out, (args.sub & 4) ? (float*)(ws + WS_PROJ) : args.out, YEXP, TOKI, CNT, args.in[7], lds, tid, wave, lane, vcu, G);
#ifdef DBG_TPHASE
    __syncthreads(); STAMP(10);
#endif
#undef IN
#undef SEAM
}

#if DBG_STAGE >= 0
__device__ __forceinline__ float block_sum256(float v, float* sh) {
    v = wave_sum(v); if ((threadIdx.x & 63) == 0) sh[threadIdx.x >> 6] = v; __syncthreads();
    float r = 0.f; for (int i = 0; i < (int)(blockDim.x >> 6); ++i) r += sh[i]; __syncthreads(); return r;
}
__device__ __forceinline__ void dbg_report(unsigned* ctl, float err) { if (threadIdx.x == 0) atomicMax(ctl + CW_DBG, __float_as_uint(fabsf(err))); }
__global__ void dbg_fill(float* out, const unsigned* ctl) {
    const float e = __uint_as_float(ctl[CW_DBG]); const float K = 10.f * sqrtf(fminf(e, 1e4f));
    for (size_t i = (size_t)blockIdx.x * blockDim.x + threadIdx.x; i < (size_t)T * DM; i += (size_t)gridDim.x * blockDim.x) out[i] = K;
}
__global__ void dbg_check1(Args a) {
    __shared__ float sh[8];
    const unsigned s = blockIdx.x; const int row = (int)((s * 2654435761u) % (unsigned)T); const int tid = threadIdx.x;
    const float* x = a.in[0] + (size_t)row * DM; const float* g = a.in[5]; const float* w = a.in[1];
    float ss = 0.f; for (int k = tid; k < DM; k += 256) ss += x[k] * x[k];
    ss = block_sum256(ss, sh); const float rstd = rsqrtf(ss / DM + EPS);
    const bool isv = (s & 7) == 7; int n, sc;
    if (isv) { n = (int)((s * 40503u + 17u) % 512u); sc = 1024 + n; } else { n = (int)((s * 40503u + 17u) % 5416u); sc = srccol_in(n); }
    float acc = 0.f; for (int k = tid; k < DM; k += 256) acc += x[k] * rstd * g[k] * w[(size_t)k * 5928 + sc];
    acc = block_sum256(acc, sh);
    const bf16* PROJ = (const bf16*)(a.ws + WS_PROJ); const bf16* VT = (const bf16*)(a.ws + WS_VT);
    const float got = isv ? bf2f(VT[(size_t)n * T + row]) : bf2f(PROJ[(size_t)row * NPJ + n]);
    dbg_report((unsigned*)(a.ws + WS_CTL), got - acc);
}
__global__ void dbg_check9(Args a) {
    __shared__ float h2[1024], gu[2048], act[1024], ysum[1024], lg[32], gt[4], sh[8]; __shared__ int te[4];
    const unsigned s = blockIdx.x; const int t = (int)((s * 2654435761u) % (unsigned)T); const int tid = threadIdx.x;
    const float* x = a.in[0] + (size_t)t * DM;
    float ss = 0.f; for (int k = tid; k < DM; k += 256) ss += x[k] * x[k];
    ss = block_sum256(ss, sh); const float rstd = rsqrtf(ss / DM + EPS);
    for (int k = tid; k < DM; k += 256) { h2[k] = x[k] * rstd * a.in[6][k]; ysum[k] = 0.f; }
    __syncthreads();
    if (tid < 32) { float acc = 0.f; for (int k = 0; k < DM; ++k) acc += h2[k] * a.in[11][(size_t)k * 32 + tid]; lg[tid] = acc + a.in[12][tid]; }
    __syncthreads();
    if (tid == 0) { float v[32]; for (int e = 0; e < 32; ++e) v[e] = lg[e]; float tv[4];
        for (int k = 0; k < 4; ++k) { int be = 0; for (int e = 1; e < 32; ++e) if (lg[e] > lg[be]) be = e; te[k] = be; tv[k] = lg[be]; lg[be] = -INFINITY; }
        float den = 0.f; for (int k = 0; k < 4; ++k) den += expf(tv[k] - tv[0]); for (int k = 0; k < 4; ++k) gt[k] = expf(tv[k] - tv[0]) / den; (void)v; }
    __syncthreads();
    for (int k4 = 0; k4 < 4; ++k4) { const int e = te[k4];
        const float* wg = a.in[13] + (size_t)e * DM * 2048; const float* wd = a.in[15] + (size_t)e * DFF * DM;
        for (int n = tid; n < 2048; n += 256) { float acc = 0.f; for (int k = 0; k < DM; ++k) acc += h2[k] * wg[(size_t)k * 2048 + n]; gu[n] = acc + a.in[14][e * 2048 + n]; }
        __syncthreads();
        for (int j = tid; j < DFF; j += 256) { const float g = fminf(gu[j], 7.f), l = fminf(fmaxf(gu[1024 + j], -7.f), 7.f); act[j] = (l + 1.f) * g / (1.f + expf(-1.702f * g)); }
        __syncthreads();
        for (int n = tid; n < DM; n += 256) { float acc = 0.f; for (int j = 0; j < DFF; ++j) acc += act[j] * wd[(size_t)j * DM + n]; ysum[n] += gt[k4] * (acc + a.in[16][e * DM + n]); }
        __syncthreads();
    }
    float s2 = 0.f; for (int k = tid; k < DM; k += 256) { const float v = x[k] + ysum[k]; s2 += v * v; }
    s2 = block_sum256(s2, sh); const float r2 = rsqrtf(s2 / DM + EPS);
    float me = 0.f; for (int k = tid; k < DM; k += 256) { const float ref = (x[k] + ysum[k]) * r2 * a.in[7][k]; me = fmaxf(me, fabsf(a.out[(size_t)t * DM + k] - ref)); }
    atomicMax((unsigned*)(a.ws + WS_CTL) + CW_DBG, __float_as_uint(me));
}
#if DBG_STAGE == 1
#define DBG_KERNEL dbg_check1
#elif DBG_STAGE == 9
#define DBG_KERNEL dbg_check9
#endif
static void dbg_launch(Args a, hipStream_t stream) {
    hipLaunchKernelGGL(DBG_KERNEL, dim3(256), dim3(256), 0, stream, a);
    hipLaunchKernelGGL(dbg_fill, dim3(2048), dim3(256), 0, stream, a.out, (const unsigned*)(a.ws + WS_CTL));
}
#endif
#ifdef DBG_TPHASE
__global__ void dbg_tfill(float* out, const unsigned long long* ts) {
    const float us = (float)(ts[DBG_TPHASE + 1] - ts[DBG_TPHASE]) * 0.01f; const float K = 10.f * sqrtf(us * 0.001f);
    for (size_t i = (size_t)blockIdx.x * blockDim.x + threadIdx.x; i < (size_t)T * DM; i += (size_t)gridDim.x * blockDim.x) out[i] = K;
}
#endif

extern "C" void kernel_launch(void* const* d_in, const int* in_sizes, int n_in, void* d_out, int out_size, void* d_ws, size_t ws_size, hipStream_t stream) {
    static int grid = 0;
    if (grid == 0) {
        if (n_in != 17 || out_size != T * DM || ws_size < WS_END) { fprintf(stderr, "kernel_launch: unexpected shapes (n_in %d out %d ws %zu, need %zu)\n", n_in, out_size, ws_size, (size_t)WS_END); grid = -1; return; }
        int dev = 0, cus = 0, per_cu = 0;
        if (hipGetDevice(&dev) != hipSuccess || hipDeviceGetAttribute(&cus, hipDeviceAttributeMultiprocessorCount, dev) != hipSuccess) { grid = -1; return; }
        if (hipFuncSetAttribute((const void*)mk_fwd, hipFuncAttributeMaxDynamicSharedMemorySize, LDS_BYTES) != hipSuccess) { fprintf(stderr, "kernel_launch: hipFuncSetAttribute failed\n"); grid = -1; return; }
        if (hipOccupancyMaxActiveBlocksPerMultiprocessor(&per_cu, (const void*)mk_fwd, 512, LDS_BYTES) != hipSuccess || per_cu < 1) fprintf(stderr, "kernel_launch: occupancy query says %d\n", per_cu);
        (void)hipGetLastError();
        grid = cus;
    }
    if (grid < 0) return;
    (void)hipMemsetAsync((char*)d_ws + WS_CTL, 0, CTL_ZERO_BYTES, stream);
    Args a{};
    for (int i = 0; i < 17; ++i) a.in[i] = (const float*)d_in[i];
    a.out = (float*)d_out; a.ws = (unsigned char*)d_ws; a.sub = 3;
#if DBG_STAGE >= 0
    const int last = DBG_STAGE + 1;
#else
    const int last = NPHASE;
#endif
#ifdef DUP_PHASE
    { const int cuts[4] = {0, DUP_PHASE + 1, DUP_PHASE, DUP_PHASE + 1}; const int ends[3] = {DUP_PHASE + 1, DUP_PHASE + 1, NPHASE};
      for (int li = 0; li < 3; ++li) { a.ph_lo = li == 0 ? 0 : (li == 1 ? DUP_PHASE : DUP_PHASE + 1); a.ph_hi = ends[li]; (void)cuts;
          if (DUP_PHASE == 9) { if (li == 0) { a.ph_hi = 9; } else { a.ph_lo = 9; a.ph_hi = 10; } }
          if (a.ph_lo >= a.ph_hi) continue;
          a.sub = 3;
#ifdef DUP_SUB
          if (li == 1) a.sub = DUP_SUB;
#endif
          if (DUP_PHASE == 9 && li == 1) a.sub = 7;
          if (li > 0) (void)hipMemsetAsync((char*)d_ws + WS_CTL + CW_BAR * 4, 0, XCD_BAR_WORDS * 4, stream);
          if (li == 1 && DUP_PHASE == 6) (void)hipMemsetAsync((char*)d_ws + WS_CTL + CW_CNT * 4, 0, 16 * 32 * 4, stream);
          hipLaunchKernelGGL(mk_fwd, dim3(grid), dim3(512), LDS_BYTES, stream, a); } }
#else
    if (MK_N_LAUNCHES == 1) { a.ph_lo = 0; a.ph_hi = last; hipLaunchKernelGGL(mk_fwd, dim3(grid), dim3(512), LDS_BYTES, stream, a); }
    else for (int p = 0; p < last; ++p) { a.ph_lo = p; a.ph_hi = p + 1; hipLaunchKernelGGL(mk_fwd, dim3(grid), dim3(512), LDS_BYTES, stream, a); }
#endif
#if DBG_STAGE >= 0
    dbg_launch(a, stream);
#endif
#ifdef HG_PROBE_RUN
    (void)hipMemsetAsync((char*)d_ws + WS_CTL + CW_BAR * 4, 0, XCD_BAR_WORDS * 4, stream); (void)hipMemsetAsync((char*)d_ws + WS_CTL + CW_TICK * 4, 0, 8 * 64 * 4, stream);
    a.ph_lo = 3; a.ph_hi = 4; a.sub = 2 | 16; hipLaunchKernelGGL(mk_fwd, dim3(grid), dim3(512), LDS_BYTES, stream, a);
#endif
#ifdef F8_PROBE
    (void)hipMemsetAsync((char*)d_ws + WS_CTL + CW_BAR * 4, 0, XCD_BAR_WORDS * 4, stream); (void)hipMemsetAsync((char*)d_ws + WS_CTL + CW_TICK * 4, 0, 8 * 64 * 4, stream);
    a.ph_lo = 7; a.ph_hi = 8; a.sub = 3 | 8; hipLaunchKernelGGL(mk_fwd, dim3(grid), dim3(512), LDS_BYTES, stream, a);
#endif
#ifdef DBG_TPHASE
    hipLaunchKernelGGL(dbg_tfill, dim3(2048), dim3(256), 0, stream, a.out, (const unsigned long long*)((unsigned*)a.ws + 2048));
#endif
}
```

```cpp
#define MOE_F8 1
#include <hip/hip_runtime.h>
#include <cstdio>
#include <cstdint>

#ifndef MK_N_LAUNCHES
#define MK_N_LAUNCHES 1
#endif
#ifndef MOE_F8
#define MOE_F8 0
#endif
#ifndef DBG_STAGE
#define DBG_STAGE -1
#endif

#define GAS __attribute__((address_space(1)))
#define LAS __attribute__((address_space(3)))
typedef unsigned short bf16;
typedef short bf16x8 __attribute__((ext_vector_type(8)));
typedef short s16x4 __attribute__((ext_vector_type(4)));
typedef float f32x2 __attribute__((ext_vector_type(2)));
typedef float f32x4 __attribute__((ext_vector_type(4)));
typedef float f32x16 __attribute__((ext_vector_type(16)));
typedef unsigned u32x2 __attribute__((ext_vector_type(2)));
typedef unsigned u32x4 __attribute__((ext_vector_type(4)));

constexpr int BATCH = 8, SEQ = 4096, DM = 1024, T = BATCH * SEQ;
constexpr int NPJ = 5632;
constexpr int C_AQ = 0, C_AK = 512, C_IQ = 1024, C_BQ = 1280, C_BF = 1792, C_BI = 2304, C_BG = 2816, C_GA = 3328, C_GB = 4352, C_IW = 5376, C_IK = 5384;
constexpr int NEXP = 32, DFF = 1024, TOPK = 4;
constexpr float EPS = 1e-6f;
constexpr int NPHASE = 10;
constexpr int F8P = 1024;

constexpr size_t MiB = 1u << 20;
constexpr size_t WS_CTL = 0, CTL_ZERO_BYTES = 1 * MiB;
constexpr size_t WS_WRH = 1 * MiB, WS_WRL = 1 * MiB + 65536;
constexpr size_t WS_WIN = 2 * MiB, WS_WV = 13 * MiB, WS_WUA = 14 * MiB, WS_WUB = 15 * MiB, WS_WO = 16 * MiB, WS_WGU = 18 * MiB, WS_WDN = 146 * MiB;
constexpr size_t WS_TOKL = 210 * MiB, WS_TOKI = 214 * MiB, WS_XN = 216 * MiB, WS_PROJ = 280 * MiB;
constexpr size_t WS_E = 632 * MiB;
constexpr size_t WS_VT = WS_E, WS_MASK = WS_E + 32 * MiB, WS_YA = WS_E + 48 * MiB, WS_YB = WS_E + 80 * MiB, WS_MRG = WS_E + 112 * MiB, WS_HU = WS_E + 176 * MiB, WS_HD = WS_E + 208 * MiB;
constexpr size_t WS_ACT = WS_PROJ, WS_YEXP = WS_E;
constexpr size_t WS_END = 904 * MiB;
constexpr int CW_TMO = 0, CW_CODE = 1, CW_CNT = 64  , CW_DBG = 1024, CW_TICK = 2048  , CW_BAR = 4096;

constexpr int RING_BYTES = 131072, MISC_OFF = RING_BYTES + 320, LDS_BYTES = 147456;

#ifdef WEIGHTS_IN_GLOBALS
__device__ unsigned char g_wgu8[(size_t)32 * 2048 * 1024];
__device__ unsigned char g_wdn8[(size_t)32 * 1024 * 1024];
#endif
struct Args { const float* in[17]; float* out; unsigned char* ws; int ph_lo, ph_hi, sub, pad; };
__device__ __forceinline__ unsigned cvt_pk_bf16(float lo, float hi) { unsigned r; asm volatile("v_cvt_pk_bf16_f32 %0, %1, %2" : "=v"(r) : "v"(lo), "v"(hi)); return r; }
__device__ __forceinline__ unsigned cvt4_fp8(float a, float b, float c, float d) { unsigned w = 0u; w = (unsigned)__builtin_amdgcn_cvt_pk_fp8_f32(a, b, (int)w, false); w = (unsigned)__builtin_amdgcn_cvt_pk_fp8_f32(c, d, (int)w, true); return w; }
__device__ __forceinline__ float bf2f(unsigned short b) { return __uint_as_float((unsigned)b << 16); }
__device__ __forceinline__ float bflo(unsigned w) { return __uint_as_float(w << 16); }
__device__ __forceinline__ float bfhi(unsigned w) { return __uint_as_float(w & 0xffff0000u); }
__device__ __forceinline__ float sigmoidf_(float x) { return __builtin_amdgcn_rcpf(1.0f + __expf(-x)); }
__device__ __forceinline__ float wave_sum(float v) {
#pragma unroll
    for (int o = 1; o < 64; o <<= 1) v += __shfl_xor(v, o);
    return v;
}
#define LDS_WAIT() asm volatile("s_waitcnt lgkmcnt(0)" ::: "memory")
#define VM_WAIT() asm volatile("s_waitcnt vmcnt(0)" ::: "memory")

#define XB_TMO      128
#define XB_XCNT(j)  (256  + 64 * (j))
#define XB_XSUB(j)  (1280 + 64 * (j))
#define XB_XGEN(j)  (2304 + 64 * (j))
#define XB_TOP      3328
#define XB_TOPGEN   3392
#define XCD_BAR_WORDS 3456
#define XB_SPIN_CAP (1u << 18)
__device__ __forceinline__ unsigned xb_ld(unsigned* p)              { return __hip_atomic_load(p, __ATOMIC_RELAXED, __HIP_MEMORY_SCOPE_AGENT); }
__device__ __forceinline__ unsigned xb_add(unsigned* p, unsigned v) { return __hip_atomic_fetch_add(p, v, __ATOMIC_RELAXED, __HIP_MEMORY_SCOPE_AGENT); }
__device__ __forceinline__ unsigned xb_xcc_id() { return (unsigned)__builtin_amdgcn_s_getreg((3 << 11) | 20) & 0xFu; }
#define XB_SPIN(cond, bar) do { unsigned _sp = 0; while (cond) { __builtin_amdgcn_s_sleep(1); \
    if ((++_sp & 255u) == 0u) { if (xb_ld(&(bar)[XB_TMO])) break; if (_sp > XB_SPIN_CAP) { atomicAdd(&(bar)[XB_TMO], 1u); break; } } } } while (0)
struct XcdBarrier { unsigned* bar; unsigned x; volatile LAS unsigned* st; };
__device__ __forceinline__ XcdBarrier xcd_barrier_post(unsigned* bar, volatile LAS unsigned* st) {
    XcdBarrier b; b.bar = bar; b.x = xb_xcc_id(); b.st = st;
    if (threadIdx.x == 0) (void)xb_add(&bar[XB_XCNT(b.x)], 1u);
    return b;
}
__device__ __forceinline__ void xcd_barrier_complete(unsigned* bar, unsigned x, unsigned& nloc, unsigned& nx) {
    const unsigned G = gridDim.x * gridDim.y * gridDim.z;
    unsigned sum, cnt, mine, sp = 0u;
    for (;;) {
        sum = 0u; cnt = 0u; mine = 0u;
#pragma unroll
        for (unsigned j = 0; j < 16; ++j) { const unsigned c = xb_ld(&bar[XB_XCNT(j)]); sum += c; cnt += (c > 0u) ? 1u : 0u; mine = (j == x) ? c : mine; }
        if (sum == G) break;
        __builtin_amdgcn_s_sleep(1);
        if ((++sp & 255u) == 0u) { if (xb_ld(&bar[XB_TMO])) break; if (sp > XB_SPIN_CAP) { atomicAdd(&bar[XB_TMO], 1u); break; } }
    }
    nloc = mine > 0u ? mine : 1u; nx = cnt > 0u ? cnt : 1u;
}
__device__ __forceinline__ void xcd_barrier(const XcdBarrier& b) {
    asm volatile("s_waitcnt vmcnt(0)" ::: "memory");
    __syncthreads();
    if (threadIdx.x == 0) {
        unsigned* bar = b.bar;
        __builtin_amdgcn_s_waitcnt(0);
        unsigned nloc = b.st[0], nx = b.st[1];
        if (nloc == 0u) { xcd_barrier_complete(bar, b.x, nloc, nx); b.st[0] = nloc; b.st[1] = nx; }
        const unsigned old = xb_add(&bar[XB_XSUB(b.x)], 1u);
        const unsigned gen = old / nloc;
        if (old + 1u == (gen + 1u) * nloc) {
            __builtin_amdgcn_fence(__ATOMIC_RELEASE, "agent");
            asm volatile("s_waitcnt vmcnt(0)" ::: "memory");
            const unsigned og = xb_add(&bar[XB_TOP], 1u);
            const unsigned tg = og / nx;
            if (og + 1u == (tg + 1u) * nx) xb_add(&bar[XB_TOPGEN], 1u);
            else XB_SPIN(xb_ld(&bar[XB_TOPGEN]) == tg, bar);
            __builtin_amdgcn_fence(__ATOMIC_ACQUIRE, "agent");
            xb_add(&bar[XB_XGEN(b.x)], 1u);
            asm volatile("s_waitcnt vmcnt(0)" ::: "memory");
        } else {
            XB_SPIN(xb_ld(&bar[XB_XGEN(b.x)]) == gen, bar);
            __builtin_amdgcn_fence(__ATOMIC_ACQUIRE, "agent");
            asm volatile("s_waitcnt vmcnt(0)" ::: "memory");
        }
    }
    __syncthreads();
}
namespace pg8 {
constexpr int BM = 256, BK = 64, HALF = 128, HTB = HALF * BK * 2, STAGE_BYTES = 8 * HTB, NXCD = 8, WGM = 8;
__host__ __device__ __forceinline__ int lds_byte(int r, int c) { const int st = (r >> 4) * 2 + (c >> 5), rr = r & 15, cc = c & 31, ob = rr * 64 + cc * 2; return st * 1024 + (ob ^ (((ob >> 9) & 1) << 5)); }
__host__ __device__ __forceinline__ void stage_rc(int b, int& R, int& C) { const int st = b / 1024, sb = b % 1024, swz = sb ^ (((sb >> 9) & 1) << 5); R = (st >> 1) * 16 + swz / 64; C = (st & 1) * 32 + (swz % 64) / 2; }
__host__ __device__ __forceinline__ int perm32(int rho) { const int n = rho >> 4, i = rho & 15; return 8 * (i >> 2) + 4 * n + (i & 3); }

struct Unit { const char* A0; const char* B0; int orow, pn, e, rt; };

struct StaticSched {
    const bf16* A; const bf16* Bt; int K, nM, nN, nwg, G, c;
    __device__ __forceinline__ void init(const bf16* A_, const bf16* Bt_, int M, int N, int K_, int G_, int c_) { A = A_; Bt = Bt_; K = K_; nM = M / BM; nN = N / BM; nwg = nM * nN; G = G_; c = c_; }
    __device__ __forceinline__ bool next(int i, Unit& u) const {
        const long L = (long)i * G + c; if (L >= nwg) return false;
        int wgid = (int)L; { const int q = nwg / NXCD, r = nwg % NXCD, xcd = wgid % NXCD, off = wgid / NXCD; wgid = (xcd < r ? xcd * (q + 1) : r * (q + 1) + (xcd - r) * q) + off; }
        const int nig = WGM * nN, gid = wgid / nig, fm = gid * WGM, gsz = (nM - fm) < WGM ? (nM - fm) : WGM;
        const int pm = fm + ((wgid % nig) % gsz), pn = (wgid % nig) / gsz;
        u.A0 = (const char*)A + (size_t)pm * BM * K * 2; u.B0 = (const char*)Bt + (size_t)pn * BM * K * 2; u.orow = pm * BM; u.pn = pn; u.e = 0; u.rt = 0; return true;
    }
    __device__ __forceinline__ void offs(const Unit&, const int (&R)[2], const int (&C)[2], unsigned (&o)[2][2]) const {
#pragma unroll
        for (int h = 0; h < 2; ++h)
#pragma unroll
            for (int i = 0; i < 2; ++i) o[h][i] = (unsigned)((h * HALF + R[i]) * K + C[i]) * 2u;
    }
};

template <bool GATHER> struct MoeSched {
    const unsigned char* XA; const unsigned char* W; const int* toklist; const int* cnt  ; const LAS int* tstart; int K, npn, nrows_w  , G, c;
    __device__ __forceinline__ bool next(int i, Unit& u) const {
        const long L = (G % 8 == 0) ? (long)i * G + (long)(c % 8) * (G / 8) + c / 8 : (long)i * G + c; const int ntile = tstart[NEXP];
        if (L >= (long)ntile * npn) return false;
        const int rtg = (int)(L / npn), pn = (int)(L % npn);
        int e = 0;
#pragma unroll 1
        for (int k = 1; k < NEXP; ++k) e += (tstart[k] <= rtg) ? 1 : 0;
        e = __builtin_amdgcn_readfirstlane(e);
        u.e = e; u.rt = rtg - tstart[e]; u.pn = pn; u.orow = rtg * BM;
        u.A0 = GATHER ? (const char*)XA : (const char*)XA + (size_t)rtg * BM * K;
        u.B0 = (const char*)W + ((size_t)e * nrows_w + (size_t)pn * BM) * K;
        return true;
    }
    __device__ __forceinline__ void offs(const Unit& u, const int (&R)[2], const int (&C)[2], unsigned (&o)[2][2]) const {
        if (GATHER) {
            const int n = cnt[16 * u.e];
#pragma unroll
            for (int h = 0; h < 2; ++h)
#pragma unroll
                for (int i = 0; i < 2; ++i) { const int r = u.rt * BM + h * HALF + R[i]; const int tok = (r < n) ? toklist[u.e * T + r] : 0; o[h][i] = (unsigned)(tok * K + C[i] * 2); }
        } else {
#pragma unroll
            for (int h = 0; h < 2; ++h)
#pragma unroll
                for (int i = 0; i < 2; ++i) o[h][i] = (unsigned)((h * HALF + R[i]) * K + C[i] * 2);
        }
    }
};

typedef int v8i __attribute__((ext_vector_type(8)));
typedef int v4i __attribute__((ext_vector_type(4)));
__device__ __forceinline__ void glds16_s(const char* sbase, unsigned voff, unsigned lds_dst) { unsigned keep;
    asm volatile("s_mov_b32 %0, m0\n\ts_mov_b32 m0, %3\n\ts_nop 0\n\tglobal_load_lds_dwordx4 %1, %2\n\ts_mov_b32 m0, %0" : "=&s"(keep) : "v"(voff), "s"(sbase), "s"(lds_dst) : "memory"); }
template <class Epi, class Sched, bool F8 = false>
__device__ __forceinline__ void gemm_phase(LAS unsigned char* lds, const int K, const Sched& S, const Epi& E) {
    const int tid = threadIdx.x, wid = __builtin_amdgcn_readfirstlane(tid >> 6), lane = tid & 63, wr = wid >> 2, wc = wid & 3, fr = lane & 15, fq = lane >> 4;
    const int rbytes = F8 ? K : 2 * K;
    int nt = rbytes / (BK * 2); if constexpr (F8) asm volatile("" : "+s"(nt));
    int Rr[2], Cc[2]; unsigned voffB[2];
#pragma unroll
    for (int i = 0; i < 2; ++i) { int R, C; stage_rc(tid * 16 + i * 8192, R, C); Rr[i] = R; Cc[i] = C; const int Rb = Epi::PERM ? ((R & ~31) + perm32(R & 31)) : R; voffB[i] = (unsigned)(Rb * rbytes + C * 2); }
    const size_t kstep = (size_t)(BK * 2);
    const size_t hstep = (size_t)HALF * rbytes;
    const unsigned ldsw = (unsigned)wid * 1024u; const unsigned ldsbase = (unsigned)(uintptr_t)lds;
    const int aoff = F8 ? lds_byte(wr * 64 + fr, (fq & 1) * 8) + (fq >> 1) * 1024 : lds_byte(wr * 64 + fr, fq * 8);
    const int boff = F8 ? lds_byte(wc * 32 + fr, (fq & 1) * 8) + (fq >> 1) * 1024 : lds_byte(wc * 32 + fr, fq * 8);
    const int aoff2 = aoff ^ 32; int boffH = boff + 4 * HTB, boffH2 = (boff ^ 32) + 4 * HTB; if constexpr (F8) asm volatile("" : "+v"(boffH), "+v"(boffH2));
#define PG8_SA(b, h) (((b) * 2 + (h)) * HTB)
#define PG8_SB(b, h) ((4 + (b) * 2 + (h)) * HTB)
#define PG8_STAGE(bufoff, gbase, voff) do { _Pragma("unroll") for (int _i = 0; _i < 2; ++_i) \
        { if constexpr (F8) glds16_s((gbase), (voff)[_i], (unsigned)__builtin_amdgcn_readfirstlane((int)(ldsbase + (unsigned)(bufoff) + ldsw + _i * 8192u))); \
          else __builtin_amdgcn_global_load_lds((const unsigned*)((const char*)(gbase) + (voff)[_i]), (LAS unsigned*)(lds + (bufoff) + ldsw + _i * 8192), 16, 0, 0); } } while (0)
#define PG8_LD8(v, o1, o2, cst) do { v.lo = *(const LAS v4i*)(lds + (o1) + (cst)); v.hi = *(const LAS v4i*)(lds + (o2) + (cst)); } while (0)
#define PG8_LDA(dst, b, h) do { if constexpr (F8) { PG8_LD8(A80, aoff, aoff2, PG8_SA(b, h)); PG8_LD8(A81, aoff, aoff2, PG8_SA(b, h) + 2048); PG8_LD8(A82, aoff, aoff2, PG8_SA(b, h) + 4096); PG8_LD8(A83, aoff, aoff2, PG8_SA(b, h) + 6144); } \
        else { _Pragma("unroll") for (int m = 0; m < 4; ++m) _Pragma("unroll") for (int k = 0; k < 2; ++k) dst[m][k] = *(const LAS bf16x8*)(lds + PG8_SA(b, h) + aoff + m * 2048 + k * 1024); } } while (0)
#define PG8_LDB(dst, b, h) do { if constexpr (F8) { PG8_LD8(dst##80, boffH, boffH2, PG8_SA(b, h)); PG8_LD8(dst##81, boffH, boffH2, PG8_SA(b, h) + 2048); } \
        else { _Pragma("unroll") for (int n = 0; n < 2; ++n) _Pragma("unroll") for (int k = 0; k < 2; ++k) dst[n][k] = *(const LAS bf16x8*)(lds + PG8_SA(b, h) + boffH + n * 2048 + k * 1024); } } while (0)
#define PG8_M8(ai, bj, m, n, a8, b8) acc[ai][bj][m][n] = __builtin_amdgcn_mfma_scale_f32_16x16x128_f8f6f4(b8, a8, acc[ai][bj][m][n], 0, 0, 0, 0x7F7F7F7F, 0, 0x7F7F7F7F)
#define PG8_MMA(ai, bj, At, Bt) do { __builtin_amdgcn_s_setprio(1); \
        if constexpr (F8) { PG8_M8(ai, bj, 0, 0, A80, Bt##80); PG8_M8(ai, bj, 0, 1, A80, Bt##81); PG8_M8(ai, bj, 1, 0, A81, Bt##80); PG8_M8(ai, bj, 1, 1, A81, Bt##81); \
                            PG8_M8(ai, bj, 2, 0, A82, Bt##80); PG8_M8(ai, bj, 2, 1, A82, Bt##81); PG8_M8(ai, bj, 3, 0, A83, Bt##80); PG8_M8(ai, bj, 3, 1, A83, Bt##81); } \
        else { _Pragma("unroll") for (int m = 0; m < 4; ++m) _Pragma("unroll") for (int n = 0; n < 2; ++n) _Pragma("unroll") for (int k = 0; k < 2; ++k) acc[ai][bj][m][n] = __builtin_amdgcn_mfma_f32_16x16x32_bf16(Bt[n][k], At[m][k], acc[ai][bj][m][n], 0, 0, 0); } \
        __builtin_amdgcn_s_setprio(0); } while (0)
#define PG8_WAIT_V(n) asm volatile("s_waitcnt vmcnt(" #n ")" ::: "memory")
#define PG8_WAIT_L(n) asm volatile("s_waitcnt lgkmcnt(" #n ")" ::: "memory")
#define PG8_BAR __builtin_amdgcn_s_barrier()
#define PG8_SCHED __builtin_amdgcn_sched_barrier(0)
    Unit cur, nxt; int ui = 0;
    if (!S.next(0, cur)) return;
    f32x4 acc[2][2][4][2];
#pragma unroll
    for (int a = 0; a < 2; ++a)
#pragma unroll
        for (int b = 0; b < 2; ++b)
#pragma unroll
            for (int m = 0; m < 4; ++m)
#pragma unroll
                for (int n = 0; n < 2; ++n) acc[a][b][m][n] = (f32x4){0.f, 0.f, 0.f, 0.f};
    bf16x8 At[4][2], B0[2][2], B1[2][2]; v8i A80, A81, A82, A83, B080, B081, B180, B181;
    unsigned cO[2][2], nO[2][2];
    S.offs(cur, Rr, Cc, cO);
    const char* cA = cur.A0; const char* cB = cur.B0;
    PG8_STAGE(PG8_SB(0, 0), cB, voffB); PG8_STAGE(PG8_SB(0, 1), cB + hstep, voffB); PG8_STAGE(PG8_SA(0, 0), cA, cO[0]); PG8_STAGE(PG8_SA(0, 1), cA, cO[1]);
    if (wr == 1) PG8_BAR;
    PG8_WAIT_V(2); PG8_BAR;
    PG8_STAGE(PG8_SB(1, 0), cB + kstep, voffB); PG8_STAGE(PG8_SA(1, 0), cA + kstep, cO[0]); PG8_STAGE(PG8_SB(1, 1), cB + hstep + kstep, voffB);
    PG8_WAIT_V(6); PG8_BAR;
    for (;;) {
        const bool has_next = S.next(ui + 1, nxt);
        const char* nA = has_next ? nxt.A0 : cA; const char* nB = has_next ? nxt.B0 : cB;
        if (has_next) { S.offs(nxt, Rr, Cc, nO);
#pragma unroll
            for (int h = 0; h < 2; ++h)
#pragma unroll
                for (int i = 0; i < 2; ++i) asm volatile("" : "+v"(nO[h][i]));
        } else {
#pragma unroll
            for (int h = 0; h < 2; ++h)
#pragma unroll
                for (int i = 0; i < 2; ++i) nO[h][i] = cO[h][i]; }
#pragma unroll 1
        for (int t = 0; t < nt; t += 2) {
            if constexpr (Epi::MIDK) { if (t == (nt >> 1)) E.mid(acc, cur, wr, wc, fr, fq); }
            const bool last = (t == nt - 2);
            const char* a1 = cA + (size_t)(t + 1) * kstep;
            const char* a2 = last ? nA : cA + (size_t)(t + 2) * kstep; const char* b2 = last ? nB : cB + (size_t)(t + 2) * kstep;
            const char* a3 = a2 + kstep; const char* b3 = b2 + kstep;
            unsigned o2[2][2];
#pragma unroll
            for (int h = 0; h < 2; ++h)
#pragma unroll
                for (int i = 0; i < 2; ++i) o2[h][i] = last ? nO[h][i] : cO[h][i];
            PG8_LDB(B0, 0, 0); PG8_LDB(B1, 0, 1); PG8_SCHED; PG8_LDA(At, 0, 0); PG8_STAGE(PG8_SA(1, 1), a1, cO[1]);
            PG8_WAIT_V(8); PG8_WAIT_L(0); PG8_BAR; PG8_MMA(0, 0, At, B0); PG8_MMA(0, 1, At, B1); PG8_BAR; PG8_SCHED;
            PG8_LDA(At, 0, 1); PG8_STAGE(PG8_SB(0, 0), b2, voffB); PG8_STAGE(PG8_SB(0, 1), b2 + hstep, voffB); PG8_STAGE(PG8_SA(0, 0), a2, o2[0]);
            PG8_WAIT_V(8); PG8_WAIT_L(0); PG8_BAR; PG8_MMA(1, 0, At, B0); PG8_MMA(1, 1, At, B1); PG8_BAR; PG8_SCHED;
            PG8_LDB(B0, 1, 0); PG8_LDB(B1, 1, 1); PG8_SCHED; PG8_LDA(At, 1, 0); PG8_STAGE(PG8_SA(0, 1), a2, o2[1]);
            PG8_WAIT_V(8); PG8_WAIT_L(0); PG8_BAR; PG8_MMA(0, 0, At, B0); PG8_MMA(0, 1, At, B1); PG8_BAR; PG8_SCHED;
            PG8_LDA(At, 1, 1); PG8_STAGE(PG8_SB(1, 0), b3, voffB); PG8_STAGE(PG8_SB(1, 1), b3 + hstep, voffB); PG8_STAGE(PG8_SA(1, 0), a3, o2[0]);
            PG8_WAIT_V(8); PG8_WAIT_L(0); PG8_BAR; PG8_MMA(1, 0, At, B0); PG8_MMA(1, 1, At, B1); PG8_BAR; PG8_SCHED;
        }
        if (wr == 0) PG8_BAR;
        E(acc, cur, wr, wc, fr, fq);
        if (!has_next) break;
#pragma unroll
        for (int a = 0; a < 2; ++a)
#pragma unroll
            for (int b = 0; b < 2; ++b)
#pragma unroll
                for (int m = 0; m < 4; ++m)
#pragma unroll
                    for (int n = 0; n < 2; ++n) acc[a][b][m][n] = (f32x4){0.f, 0.f, 0.f, 0.f};
        cur = nxt; cA = nA; cB = nB; ++ui;
#pragma unroll
        for (int h = 0; h < 2; ++h)
#pragma unroll
            for (int i = 0; i < 2; ++i) cO[h][i] = nO[h][i];
        if (wr == 1) PG8_BAR;
    }
    PG8_WAIT_V(0);
    PG8_BAR;
#undef PG8_SA
#undef PG8_SB
#undef PG8_STAGE
#undef PG8_LDA
#undef PG8_LDB
#undef PG8_MMA
#undef PG8_M8
#undef PG8_LD8
#undef PG8_WAIT_V
#undef PG8_WAIT_L
#undef PG8_BAR
#undef PG8_SCHED
}

struct EpiBf16 {
    static constexpr bool PERM = true, MIDK = false;
    bf16* O; int ldc; const float* bias; int bias_ld; float scale;
    __device__ __forceinline__ void operator()(const f32x4 (&acc)[2][2][4][2], const Unit& u, int wr, int wc, int fr, int fq) const {
        const int row0 = u.orow + wr * 64 + fr, col0 = u.pn * BM + wc * 32 + 8 * fq;
        f32x4 bv[2][2];
#pragma unroll
        for (int bj = 0; bj < 2; ++bj)
#pragma unroll
            for (int n = 0; n < 2; ++n) bv[bj][n] = bias ? *(const f32x4*)(bias + (size_t)u.e * bias_ld + col0 + bj * HALF + 4 * n) : (f32x4){0.f, 0.f, 0.f, 0.f};
#pragma unroll
        for (int ai = 0; ai < 2; ++ai)
#pragma unroll
            for (int m = 0; m < 4; ++m) { bf16* rowp = O + (size_t)(row0 + ai * HALF + m * 16) * ldc + col0;
#pragma unroll
                for (int bj = 0; bj < 2; ++bj) { const f32x4 v0 = acc[ai][bj][m][0] * scale + bv[bj][0], v1 = acc[ai][bj][m][1] * scale + bv[bj][1];
                    u32x4 w; w.x = cvt_pk_bf16(v0[0], v0[1]); w.y = cvt_pk_bf16(v0[2], v0[3]); w.z = cvt_pk_bf16(v1[0], v1[1]); w.w = cvt_pk_bf16(v1[2], v1[3]);
                    *(u32x4*)(rowp + bj * HALF) = w; } }
    }
};
struct EpiMerge2 {
    static constexpr bool PERM = true, MIDK = true;
    const bf16* Ga; const bf16* Gb; bf16* O;
    __device__ __forceinline__ void mid(f32x4 (&acc)[2][2][4][2], const Unit& u, int wr, int wc, int fr, int fq) const {
        int row0 = u.orow + wr * 64 + fr, col0 = u.pn * BM + wc * 32 + 8 * fq;
        asm volatile("" : "+v"(row0), "+v"(col0));
#pragma unroll
        for (int ai = 0; ai < 2; ++ai)
#pragma unroll
            for (int m = 0; m < 4; ++m) { const size_t r = (size_t)(row0 + ai * HALF + m * 16);
#pragma unroll
                for (int bj = 0; bj < 2; ++bj) { const u32x4 ga = *(const u32x4*)(Ga + r * NPJ + col0 + bj * HALF), gb = *(const u32x4*)(Gb + r * NPJ + col0 + bj * HALF);
                    const float a8[8] = {bflo(ga.x), bfhi(ga.x), bflo(ga.y), bfhi(ga.y), bflo(ga.z), bfhi(ga.z), bflo(ga.w), bfhi(ga.w)};
                    const float b8[8] = {bflo(gb.x), bfhi(gb.x), bflo(gb.y), bfhi(gb.y), bflo(gb.z), bfhi(gb.z), bflo(gb.w), bfhi(gb.w)};
#pragma unroll
                    for (int j = 0; j < 8; ++j) { const float ratio = (1.0f + __expf(-b8[j])) * __builtin_amdgcn_rcpf(1.0f + __expf(-a8[j])); acc[ai][bj][m][j >> 2][j & 3] *= ratio; } }
                asm volatile("" ::: "memory"); }
    }
    __device__ __forceinline__ void operator()(const f32x4 (&acc)[2][2][4][2], const Unit& u, int wr, int wc, int fr, int fq) const {
        const int row0 = u.orow + wr * 64 + fr, col0 = u.pn * BM + wc * 32 + 8 * fq;
#pragma unroll
        for (int ai = 0; ai < 2; ++ai)
#pragma unroll
            for (int m = 0; m < 4; ++m) { const size_t r = (size_t)(row0 + ai * HALF + m * 16);
#pragma unroll
                for (int bj = 0; bj < 2; ++bj) { const u32x4 gw = *(const u32x4*)(Gb + r * NPJ + col0 + bj * HALF);
                    f32x4 v0 = acc[ai][bj][m][0], v1 = acc[ai][bj][m][1];
                    v0[0] *= sigmoidf_(bflo(gw.x)); v0[1] *= sigmoidf_(bfhi(gw.x)); v0[2] *= sigmoidf_(bflo(gw.y)); v0[3] *= sigmoidf_(bfhi(gw.y));
                    v1[0] *= sigmoidf_(bflo(gw.z)); v1[1] *= sigmoidf_(bfhi(gw.z)); v1[2] *= sigmoidf_(bflo(gw.w)); v1[3] *= sigmoidf_(bfhi(gw.w));
                    u32x4 w; w.x = cvt_pk_bf16(v0[0], v0[1]); w.y = cvt_pk_bf16(v0[2], v0[3]); w.z = cvt_pk_bf16(v1[0], v1[1]); w.w = cvt_pk_bf16(v1[2], v1[3]);
                    *(u32x4*)(O + r * DM + col0 + bj * HALF) = w; } }
    }
};
struct EpiOutRes {
    static constexpr bool PERM = false, MIDK = false;
    const float* X; float* O;
    __device__ __forceinline__ void operator()(const f32x4 (&acc)[2][2][4][2], const Unit& u, int wr, int wc, int fr, int fq) const {
        const int row0 = u.orow + wr * 64 + fr, col0 = u.pn * BM + wc * 32 + 4 * fq;
#pragma unroll
        for (int ai = 0; ai < 2; ++ai)
#pragma unroll
            for (int m = 0; m < 4; ++m) { const size_t off = (size_t)(row0 + ai * HALF + m * 16) * DM + col0;
#pragma unroll
                for (int bj = 0; bj < 2; ++bj)
#pragma unroll
                    for (int n = 0; n < 2; ++n) { const f32x4 xv = *(const f32x4*)(X + off + bj * HALF + n * 16); *(f32x4*)(O + off + bj * HALF + n * 16) = xv + acc[ai][bj][m][n]; } }
    }
};
struct EpiSwiGLU {
    static constexpr bool PERM = true, MIDK = false;
    const float* bgu; unsigned char* O; float scale;
    __device__ __forceinline__ void operator()(const f32x4 (&acc)[2][2][4][2], const Unit& u, int wr, int wc, int fr, int fq) const {
        const int row0 = u.orow + wr * 64 + fr, col0 = u.pn * HALF + wc * 32 + 8 * fq;
        const float* bg = bgu + (size_t)u.e * 2 * DFF + col0;
        f32x4 bgt[2], bln[2];
#pragma unroll
        for (int n = 0; n < 2; ++n) { bgt[n] = *(const f32x4*)(bg + 4 * n); bln[n] = *(const f32x4*)(bg + DFF + 4 * n); }
#pragma unroll
        for (int ai = 0; ai < 2; ++ai)
#pragma unroll
            for (int m = 0; m < 4; ++m) { float o[8];
#pragma unroll
                for (int n = 0; n < 2; ++n) { const f32x4 gt = acc[ai][0][m][n] * scale + bgt[n], ln = acc[ai][1][m][n] * scale + bln[n];
#pragma unroll
                    for (int j = 0; j < 4; ++j) { const float gg = fminf(gt[j], 7.0f), ll = fminf(fmaxf(ln[j], -7.0f), 7.0f); o[4 * n + j] = (ll + 1.0f) * gg * sigmoidf_(1.702f * gg); } }
                if (MOE_F8) { u32x2 w; w.x = cvt4_fp8(o[0], o[1], o[2], o[3]); w.y = cvt4_fp8(o[4], o[5], o[6], o[7]); *(u32x2*)(O + (size_t)(row0 + ai * HALF + m * 16) * DFF + col0) = w; }
                else { u32x4 w; w.x = cvt_pk_bf16(o[0], o[1]); w.y = cvt_pk_bf16(o[2], o[3]); w.z = cvt_pk_bf16(o[4], o[5]); w.w = cvt_pk_bf16(o[6], o[7]); *(u32x4*)((bf16*)O + (size_t)(row0 + ai * HALF + m * 16) * DFF + col0) = w; } }
    }
};
}

namespace f8g {
#ifndef F8_AUX_A
#define F8_AUX_A 0
#endif
#ifndef F8_AUX_B
#define F8_AUX_B 0
#endif
#ifndef F8_NLOAD
#define F8_NLOAD 4
#endif
#ifndef F8_REGSTAGE
#define F8_REGSTAGE 0
#endif
constexpr int BMR = 256, BNC = 256, HT = 16384, STG = 4 * HT;
__host__ __device__ __forceinline__ int img_byte(int r, int gran) { return (r >> 3) * 1024 + (r & 7) * 128 + 16 * (gran ^ ((r >> 1) & 7)); }
__host__ __device__ __forceinline__ void img_rc(int b, int& R, int& Cb) { const int ch = b >> 10, rr = (b >> 7) & 7; R = ch * 8 + rr; Cb = 16 * (((b >> 4) & 7) ^ ((R >> 1) & 7)); }
struct Unit { const char* A0; const char* B0; int orow, pn, e, rt; };
template <bool GATHER> struct Sched {
    const unsigned char* XA; const unsigned char* W; const int* toklist; const int* cnt; const LAS int* tstart; int K  , npn, nrows_w, G, c;
    __device__ __forceinline__ bool next(int i, Unit& u) const {
        const int L = i * G + c; const int ntile = tstart[NEXP];
        if (L >= ntile * npn) return false;
        const int sh = __builtin_ctz((unsigned)npn); const int rtg = L >> sh, pn = L & (npn - 1);
        const int ln = (int)(threadIdx.x & 63); const int tv = tstart[ln < NEXP ? ln : 0];
        int e = __popcll(__ballot(ln >= 1 && ln < NEXP && tv <= rtg));
        e = __builtin_amdgcn_readfirstlane(e);
        u.e = e; u.rt = rtg - tstart[e]; u.pn = pn; u.orow = rtg * BMR;
        u.A0 = GATHER ? (const char*)XA : (const char*)XA + (size_t)rtg * BMR * F8P;
        u.B0 = (const char*)W + ((size_t)e * nrows_w + (size_t)pn * BNC) * K;
        return true;
    }
    __device__ __forceinline__ void offs(const Unit& u, const int (&R)[16 / F8_NLOAD], const int (&C)[16 / F8_NLOAD], unsigned (&o)[2][16 / F8_NLOAD]) const {
        if (GATHER) { const int n = cnt[16 * u.e];
#pragma unroll
            for (int h = 0; h < 2; ++h)
#pragma unroll
                for (int i = 0; i < 16 / F8_NLOAD; ++i) { const int r = u.rt * BMR + h * 128 + R[i]; const int tok = (r < n) ? toklist[u.e * T + r] : 0; o[h][i] = (unsigned)(tok * F8P + C[i] * 2); }
        } else {
#pragma unroll
            for (int h = 0; h < 2; ++h)
#pragma unroll
                for (int i = 0; i < 16 / F8_NLOAD; ++i) o[h][i] = (unsigned)((h * 128 + R[i]) * F8P + C[i] * 2);
        }
    }
};
typedef int v8i __attribute__((ext_vector_type(8)));
typedef int v4i __attribute__((ext_vector_type(4)));
template <class Epi, class S_, int PROBE = 0>
__device__ __forceinline__ void gemm(LAS unsigned char* lds, const int K, const S_& S, const Epi& E) {
    const int tid = threadIdx.x, wid = __builtin_amdgcn_readfirstlane(tid >> 6), lane = tid & 63, wr = wid >> 2, wc = wid & 3, fr = lane & 15, fq = lane >> 4;
    int nt = K / 128; asm volatile("" : "+s"(nt));
    const bool loader = wid < F8_NLOAD;
    int Rr[16 / F8_NLOAD], Cc[16 / F8_NLOAD]; unsigned voffB[16 / F8_NLOAD];
#pragma unroll
    for (int i = 0; i < 16 / F8_NLOAD; ++i) { int R, Cb; img_rc(((wid & (F8_NLOAD - 1)) + F8_NLOAD * i) * 1024 + lane * 16, R, Cb); Rr[i] = R; Cc[i] = Cb >> 1; voffB[i] = (unsigned)(R * 128 + Cb); }
    const unsigned ldsw = (unsigned)(wid & (F8_NLOAD - 1)) * 1024u;
    const size_t hstepB = (size_t)128 * 128;
    const int aoff = img_byte(fr, fq) + wr * HT, aoff2 = aoff ^ 64;
    const int boff = img_byte((wc & 1) * 64 + fr, fq) + (2 + (wc >> 1)) * HT, boff2 = boff ^ 64;
#define F8_STAGE(stg, abase, ao, bbase) do { if (loader) { _Pragma("unroll") for (int _i = 0; _i < 16 / F8_NLOAD; ++_i) { \
        __builtin_amdgcn_global_load_lds((const unsigned*)((abase) + (ao)[0][_i]), (LAS unsigned*)(lds + (stg) * STG + ldsw + _i * (F8_NLOAD * 1024)), 16, 0, F8_AUX_A); \
        __builtin_amdgcn_global_load_lds((const unsigned*)((abase) + (ao)[1][_i]), (LAS unsigned*)(lds + (stg) * STG + HT + ldsw + _i * (F8_NLOAD * 1024)), 16, 0, F8_AUX_A); \
        __builtin_amdgcn_global_load_lds((const unsigned*)((bbase) + voffB[_i]), (LAS unsigned*)(lds + (stg) * STG + 2 * HT + ldsw + _i * (F8_NLOAD * 1024)), 16, 0, F8_AUX_B); \
        __builtin_amdgcn_global_load_lds((const unsigned*)((bbase) + hstepB + voffB[_i]), (LAS unsigned*)(lds + (stg) * STG + 3 * HT + ldsw + _i * (F8_NLOAD * 1024)), 16, 0, F8_AUX_B); } } } while (0)
    u32x4 rg[8];
#define F8_GLOAD(abase, ao, bbase) do { _Pragma("unroll") for (int _i = 0; _i < 2; ++_i) { \
        rg[0 + _i] = *(const u32x4*)((abase) + (ao)[0][_i]); rg[2 + _i] = *(const u32x4*)((abase) + (ao)[1][_i]); \
        rg[4 + _i] = *(const u32x4*)((bbase) + voffB[_i]); rg[6 + _i] = *(const u32x4*)((bbase) + hstepB + voffB[_i]); } } while (0)
#define F8_LSTORE(stg) do { _Pragma("unroll") for (int _i = 0; _i < 2; ++_i) { const unsigned o_ = (stg) * STG + ldsw + _i * 8192 + (unsigned)lane * 16u; \
        *(LAS u32x4*)(lds + o_) = rg[0 + _i]; *(LAS u32x4*)(lds + o_ + HT) = rg[2 + _i]; *(LAS u32x4*)(lds + o_ + 2 * HT) = rg[4 + _i]; *(LAS u32x4*)(lds + o_ + 3 * HT) = rg[6 + _i]; } } while (0)
    Unit cur, nxt; int ui = 0;
    if (!S.next(0, cur)) return;
    f32x4 acc[8][4];
#pragma unroll
    for (int m = 0; m < 8; ++m)
#pragma unroll
        for (int n = 0; n < 4; ++n) acc[m][n] = (f32x4){0.f, 0.f, 0.f, 0.f};
    unsigned cO[2][16 / F8_NLOAD], nO[2][16 / F8_NLOAD];
    S.offs(cur, Rr, Cc, cO);
#if F8_REGSTAGE
    F8_GLOAD(cur.A0, cO, cur.B0); F8_LSTORE(0);
#else
    F8_STAGE(0, cur.A0, cO, cur.B0);
#endif
    int stg = 0;
    for (;;) {
        const bool has_next = S.next(ui + 1, nxt);
        if (has_next) { S.offs(nxt, Rr, Cc, nO);
#pragma unroll
            for (int h = 0; h < 2; ++h)
#pragma unroll
                for (int i = 0; i < 16 / F8_NLOAD; ++i) asm volatile("" : "+v"(nO[h][i])); }
        else {
#pragma unroll
            for (int h = 0; h < 2; ++h)
#pragma unroll
                for (int i = 0; i < 16 / F8_NLOAD; ++i) nO[h][i] = cO[h][i]; }
#pragma unroll 1
        for (int t = 0; t < nt; ++t) {
#if F8_REGSTAGE
            __syncthreads();
#else
            asm volatile("s_waitcnt vmcnt(0)" ::: "memory"); __builtin_amdgcn_s_barrier();
#endif
            { const int t2 = t + 1; const bool wrap = t2 >= nt; const char* ab = wrap ? (has_next ? nxt.A0 : cur.A0) : cur.A0; const char* bb = wrap ? (has_next ? nxt.B0 : cur.B0) : cur.B0;
              const int kb = wrap ? 0 : t2 * 128; unsigned o2[2][16 / F8_NLOAD];
#pragma unroll
              for (int h = 0; h < 2; ++h)
#pragma unroll
                  for (int i = 0; i < 16 / F8_NLOAD; ++i) o2[h][i] = wrap ? nO[h][i] : cO[h][i];
#if F8_REGSTAGE
              F8_GLOAD(ab + kb, o2, bb + (size_t)kb * 256); }
#else
              F8_STAGE(stg ^ 1, ab + kb, o2, bb + (size_t)kb * 256); }
#endif
            const LAS unsigned char* sb = lds + stg * STG;
            if (PROBE == 2) { stg ^= 1; continue; }
            v8i B8[4];
#pragma unroll
            for (int n = 0; n < 4; ++n) { B8[n].lo = *(const LAS v4i*)(sb + boff + n * 2048); B8[n].hi = *(const LAS v4i*)(sb + boff2 + n * 2048); }
            v8i A8c, A8n; A8c.lo = *(const LAS v4i*)(sb + aoff); A8c.hi = *(const LAS v4i*)(sb + aoff2);
#pragma unroll
            for (int m = 0; m < 8; ++m) {
                if (m < 7) { A8n.lo = *(const LAS v4i*)(sb + aoff + (m + 1) * 2048); A8n.hi = *(const LAS v4i*)(sb + aoff2 + (m + 1) * 2048); }
                __builtin_amdgcn_s_setprio(1);
#pragma unroll
                for (int n = 0; n < 4; ++n) { if (PROBE == 1) { acc[m][n][0] += __int_as_float(B8[n][0] ^ A8c[0]); acc[m][n][1] += __int_as_float(B8[n][7] ^ A8c[7]); } else acc[m][n] = __builtin_amdgcn_mfma_scale_f32_16x16x128_f8f6f4(B8[n], A8c, acc[m][n], 0, 0, 0, 0x7F7F7F7F, 0, 0x7F7F7F7F); }
                __builtin_amdgcn_s_setprio(0);
                A8c = A8n; }
#if F8_REGSTAGE
            F8_LSTORE(stg ^ 1);
#endif
            stg ^= 1;
        }
        E(acc, cur, wr, wc, fr, fq);
        if (!has_next) break;
#pragma unroll
        for (int m = 0; m < 8; ++m)
#pragma unroll
            for (int n = 0; n < 4; ++n) acc[m][n] = (f32x4){0.f, 0.f, 0.f, 0.f};
        cur = nxt; ++ui;
#pragma unroll
        for (int h = 0; h < 2; ++h)
#pragma unroll
            for (int i = 0; i < 16 / F8_NLOAD; ++i) cO[h][i] = nO[h][i];
    }
    asm volatile("s_waitcnt vmcnt(0)" ::: "memory"); __builtin_amdgcn_s_barrier();
#undef F8_STAGE
#undef F8_GLOAD
#undef F8_LSTORE
}
struct EpiSwiGLU8 {
    const float* bgu; unsigned char* O;
    __device__ __forceinline__ void operator()(const f32x4 (&acc)[8][4], const Unit& u, int wr, int wc, int fr, int fq) const {
        const int row0 = u.orow + wr * 128 + fr, col0 = u.pn * 128 + wc * 32 + 4 * fq;
        const float* bg = bgu + (size_t)u.e * 2 * DFF + col0;
        f32x4 bgt[2], bln[2];
#pragma unroll
        for (int n = 0; n < 2; ++n) { bgt[n] = *(const f32x4*)(bg + 16 * n); bln[n] = *(const f32x4*)(bg + DFF + 16 * n); }
#pragma unroll
        for (int m = 0; m < 8; ++m)
#pragma unroll
            for (int n = 0; n < 2; ++n) { const f32x4 gt = acc[m][n] * (1.f / 32.f) + bgt[n], ln = acc[m][2 + n] * (1.f / 32.f) + bln[n]; float o[4];
#pragma unroll
                for (int j = 0; j < 4; ++j) { const float gg = fminf(gt[j], 7.0f), ll = fminf(fmaxf(ln[j], -7.0f), 7.0f); o[j] = (ll + 1.0f) * gg * __builtin_amdgcn_rcpf(1.0f + __builtin_amdgcn_exp2f(gg * (-1.702f * 1.44269504f))); }
                *(unsigned*)(O + (size_t)(row0 + m * 16) * F8P + col0 + 16 * n) = cvt4_fp8(o[0], o[1], o[2], o[3]); }
    }
};
struct EpiDown8 {
    const float* bias; bf16* O;
    __device__ __forceinline__ void operator()(const f32x4 (&acc)[8][4], const Unit& u, int wr, int wc, int fr, int fq) const {
        const int row0 = u.orow + wr * 128 + fr, col0 = u.pn * BNC + wc * 64 + 4 * fq;
        f32x4 bv[4];
#pragma unroll
        for (int n = 0; n < 4; ++n) bv[n] = *(const f32x4*)(bias + (size_t)u.e * DM + col0 + 16 * n);
#pragma unroll
        for (int m = 0; m < 8; ++m)
#pragma unroll
            for (int n = 0; n < 4; ++n) { const f32x4 v = acc[m][n] * (1.f / 32.f) + bv[n]; u32x2 w; w.x = cvt_pk_bf16(v[0], v[1]); w.y = cvt_pk_bf16(v[2], v[3]);
                *(u32x2*)(O + (size_t)(row0 + m * 16) * DM + col0 + 16 * n) = w; }
    }
};
}
__device__ __forceinline__ int srccol_in(int n) {
    if (n < 1024) return n;
    if (n < 1280) return 1536 + (n - 1024);
    if (n < 1792) return 1832 + (n - 1280);
    if (n < 2304) return 2344 + (n - 1792);
    if (n < 2816) return 2856 + (n - 2304);
    if (n < 3328) return 3368 + (n - 2816);
    if (n < 4352) return 3880 + (n - 3328);
    if (n < 5376) return 4904 + (n - 4352);
    if (n < 5384) return 1792 + (n - 5376);
    if (n < 5416) return 1800 + (n - 5384);
    return -1;
}
template <int MAP> __device__ __forceinline__ int srccol(int n) {
    if (MAP == 1) return srccol_in(n);
    if (MAP == 2) return 1024 + n;
    if (MAP == 3) { const int pn = n >> 8, j = n & 255; return j < 128 ? pn * 128 + j : 1024 + pn * 128 + (j - 128); }
    if (MAP == 4) { const int pn = n >> 8, j = n & 255, q = j >> 5; return (q & 1 ? 1024 : 0) + 128 * pn + 32 * (q >> 1) + (j & 31); }
    return n;
}
template <int MAP, bool F8 = false> __device__ __forceinline__ void tr_item(const float* W, int ldw, int Kd  , bf16* WT, int k0, int n0, LAS float* scr, int lane) {
    const int nq = lane & 7, sc = srccol<MAP>(n0 + 4 * nq);
#pragma unroll
    for (int i = 0; i < 8; ++i) { const int kk = (lane >> 3) + 8 * i;
        f32x4 v = (f32x4){0.f, 0.f, 0.f, 0.f}; if (sc >= 0) v = *(const f32x4*)(W + (size_t)(k0 + kk) * ldw + sc);
        LAS float* d = scr + kk * 33 + 4 * nq; d[0] = v[0]; d[1] = v[1]; d[2] = v[2]; d[3] = v[3]; }
    LDS_WAIT(); asm volatile("" ::: "memory");
    const int c = lane & 7;
#pragma unroll
    for (int j = 0; j < 4; ++j) { const int n = (lane >> 3) + 8 * j; const LAS float* s = scr + (8 * c) * 33 + n;
        if (F8) { u32x2 o; o.x = cvt4_fp8(s[0 * 33] * 32.f, s[1 * 33] * 32.f, s[2 * 33] * 32.f, s[3 * 33] * 32.f); o.y = cvt4_fp8(s[4 * 33] * 32.f, s[5 * 33] * 32.f, s[6 * 33] * 32.f, s[7 * 33] * 32.f);
            const int nn = n0 + n, kk = k0 + 8 * c; *(u32x2*)((unsigned char*)WT + ((size_t)(nn >> 8) * (Kd >> 7) + (kk >> 7)) * 32768 + (size_t)(nn & 255) * 128 + (kk & 127)) = o; }
        else { u32x4 o; o.x = cvt_pk_bf16(s[0 * 33], s[1 * 33]); o.y = cvt_pk_bf16(s[2 * 33], s[3 * 33]); o.z = cvt_pk_bf16(s[4 * 33], s[5 * 33]); o.w = cvt_pk_bf16(s[6 * 33], s[7 * 33]);
            *(u32x4*)(WT + (size_t)(n0 + n) * Kd + k0 + 8 * c) = o; } }
    LDS_WAIT(); asm volatile("" ::: "memory");
}
template <int MAP, bool F8 = false> __device__ __forceinline__ void tr_matrix(const float* W, int ldw, int Kd, int Nd, bf16* WT, LAS float* scr, int lane, int gw, int NGW, int pitch = 0) {
    const int nkb = Kd / 64, nnb = Nd / 32, n = nkb * nnb; if (pitch == 0) pitch = Kd;
    for (int it = gw; it < n; it += NGW) { const int kb = it / nnb, nb = it % nnb; tr_item<MAP, F8>(W, ldw, pitch, WT, 64 * kb, 32 * nb, scr, lane); }
}
__device__ __forceinline__ void rms_row_to_bf16(const float* xrow, const float* gain, bf16* orow, int lane) {
    const f32x4* xr = (const f32x4*)xrow + lane; const f32x4* gr = (const f32x4*)gain + lane;
    f32x4 v[4]; float s = 0.f;
#pragma unroll
    for (int j = 0; j < 4; ++j) { v[j] = xr[64 * j]; s += (v[j][0] * v[j][0] + v[j][1] * v[j][1]) + (v[j][2] * v[j][2] + v[j][3] * v[j][3]); }
    const float rstd = rsqrtf(wave_sum(s) * (1.f / DM) + EPS);
    u32x2* o8 = (u32x2*)orow + lane;
#pragma unroll
    for (int j = 0; j < 4; ++j) { const f32x4 g = gr[64 * j]; u32x2 w; w.x = cvt_pk_bf16(v[j][0] * rstd * g[0], v[j][1] * rstd * g[1]); w.y = cvt_pk_bf16(v[j][2] * rstd * g[2], v[j][3] * rstd * g[3]); o8[64 * j] = w; }
}

struct P0Args { const float *x, *w_in, *w_up_a, *w_up_b, *w_out, *norm_mix, *w_gu, *w_down, *w_router; unsigned char* ws; unsigned char* wgu; unsigned char* wdn; };
__device__ __forceinline__ void p0_prologue(const P0Args& a, LAS unsigned char* lds, int wave, int lane, int vcu, int G) {
    LAS float* scr = (LAS float*)(lds + wave * 16384);
    const int gw = vcu * 8 + wave, NGW = G * 8;
    unsigned char* ws = a.ws;
    tr_matrix<1>(a.w_in, 5928, DM, NPJ, (bf16*)(ws + WS_WIN), scr, lane, gw, NGW);
    tr_matrix<2>(a.w_in, 5928, DM, 512, (bf16*)(ws + WS_WV), scr, lane, gw, NGW);
    tr_matrix<0>(a.w_up_a, DM, 512, DM, (bf16*)(ws + WS_WUA), scr, lane, gw, NGW, DM);
    tr_matrix<0>(a.w_up_b, DM, 512, DM, (bf16*)(ws + WS_WUA) + 512, scr, lane, gw, NGW, DM);
    tr_matrix<0>(a.w_out, DM, DM, DM, (bf16*)(ws + WS_WO), scr, lane, gw, NGW);
    for (int i = gw * 64 + lane; i < NEXP * DM; i += NGW * 64) { const int e = i >> 10, k = i & 1023; const float w = a.w_router[(size_t)k * NEXP + e];
        const unsigned hw = cvt_pk_bf16(w, 0.f) & 0xffffu; ((bf16*)(ws + WS_WRH))[i] = (bf16)hw; ((bf16*)(ws + WS_WRL))[i] = (bf16)(cvt_pk_bf16(w - bflo(hw), 0.f) & 0xffffu); }
    for (int m = gw; m < T; m += 4 * NGW) {
        f32x4 v[4][4]; const f32x4* gr = (const f32x4*)a.norm_mix + lane;
#pragma unroll
        for (int u = 0; u < 4; ++u) { const int r = m + u * NGW; const f32x4* xr = (const f32x4*)(a.x + (size_t)(r < T ? r : m) * DM) + lane;
#pragma unroll
            for (int j = 0; j < 4; ++j) v[u][j] = xr[64 * j]; }
#pragma unroll
        for (int u = 0; u < 4; ++u) { const int r = m + u * NGW; if (r >= T) break; float ss = 0.f;
#pragma unroll
            for (int j = 0; j < 4; ++j) ss += (v[u][j][0] * v[u][j][0] + v[u][j][1] * v[u][j][1]) + (v[u][j][2] * v[u][j][2] + v[u][j][3] * v[u][j][3]);
            const float rstd = rsqrtf(wave_sum(ss) * (1.f / DM) + EPS);
            u32x2* o8 = (u32x2*)((bf16*)(ws + WS_XN) + (size_t)r * DM) + lane;
#pragma unroll
            for (int j = 0; j < 4; ++j) { const f32x4 g = gr[64 * j]; u32x2 w; w.x = cvt_pk_bf16(v[u][j][0] * rstd * g[0], v[u][j][1] * rstd * g[1]); w.y = cvt_pk_bf16(v[u][j][2] * rstd * g[2], v[u][j][3] * rstd * g[3]); o8[64 * j] = w; } }
    }
    for (int e = 0; e < NEXP; ++e) {
        constexpr int EB = MOE_F8 ? 1 : 2;
        tr_matrix<MOE_F8 ? 4 : 3, MOE_F8 != 0>(a.w_gu + (size_t)e * DM * 2 * DFF, 2 * DFF, DM, 2 * DFF, (bf16*)(a.wgu + (size_t)e * 2 * DFF * DM * EB), scr, lane, (gw + 61 * e) % NGW, NGW);
        tr_matrix<0, MOE_F8 != 0>(a.w_down + (size_t)e * DFF * DM, DM, DFF, DM, (bf16*)(a.wdn + (size_t)e * DM * DFF * EB), scr, lane, (gw + 37 * e) % NGW, NGW);
    }
}

struct P6Args { const float* x1; const float* norm_ffn; const bf16* wrh; const bf16* wrl; const float* b_router; unsigned char* h2; unsigned* cnt; int* tokl; u32x2* toki; };
__device__ __forceinline__ void p6_split8(const f32x4 a, const f32x4 b, const f32x4 ga, const f32x4 gb, float rs, bf16x8& hi, bf16x8& lo) {
    float v[8] = {a[0] * rs * ga[0], a[1] * rs * ga[1], a[2] * rs * ga[2], a[3] * rs * ga[3], b[0] * rs * gb[0], b[1] * rs * gb[1], b[2] * rs * gb[2], b[3] * rs * gb[3]};
    u32x4 h; h.x = cvt_pk_bf16(v[0], v[1]); h.y = cvt_pk_bf16(v[2], v[3]); h.z = cvt_pk_bf16(v[4], v[5]); h.w = cvt_pk_bf16(v[6], v[7]);
    u32x4 l; l.x = cvt_pk_bf16(v[0] - bflo(h.x), v[1] - bfhi(h.x)); l.y = cvt_pk_bf16(v[2] - bflo(h.y), v[3] - bfhi(h.y)); l.z = cvt_pk_bf16(v[4] - bflo(h.z), v[5] - bfhi(h.z)); l.w = cvt_pk_bf16(v[6] - bflo(h.w), v[7] - bfhi(h.w));
    hi = __builtin_bit_cast(bf16x8, h); lo = __builtin_bit_cast(bf16x8, l);
}
__device__ __forceinline__ void p6_router(const P6Args& a, LAS unsigned char* lds, int tid, int wave, int lane, int vcu, int G) {
    LAS float* rstd_l = (LAS float*)(lds + RING_BYTES + 1024);
    LAS unsigned* lcnt = (LAS unsigned*)(lds + RING_BYTES + 2048);
    LAS unsigned* lbase = lcnt + 32;
    LAS unsigned* lsel = lcnt + 64;
    LAS float* lgate = (LAS float*)(lcnt + 64 + 512);
    const int rows_per = 128;
    for (int i = tid; i < 8192; i += 512) { const int e = (i >> 7) & 31, hl = i >> 12, kb = (i & 127) * 16;
        *(LAS u32x4*)(lds + hl * 65536 + e * 2048 + (kb ^ ((e & 15) << 4))) = *(const u32x4*)((const unsigned char*)(hl ? a.wrl : a.wrh) + e * 2048 + kb); }
    __syncthreads();
    for (int base = vcu * rows_per; base < T; base += G * rows_per) {
        if (tid < 32) lcnt[tid] = 0u;
        __syncthreads();
#pragma unroll 1
        for (int q = 0; q < 16; q += 4) {
            f32x4 v[4][4];
#pragma unroll
            for (int u = 0; u < 4; ++u) { const f32x4* xr = (const f32x4*)(a.x1 + (size_t)(base + 16 * wave + q + u) * DM) + lane;
#pragma unroll
                for (int j = 0; j < 4; ++j) v[u][j] = xr[64 * j]; }
#pragma unroll
            for (int u = 0; u < 4; ++u) { const int t = base + 16 * wave + q + u; const f32x4* gr = (const f32x4*)a.norm_ffn + lane; float s = 0.f;
#pragma unroll
                for (int j = 0; j < 4; ++j) s += (v[u][j][0] * v[u][j][0] + v[u][j][1] * v[u][j][1]) + (v[u][j][2] * v[u][j][2] + v[u][j][3] * v[u][j][3]);
                const float rstd = rsqrtf(wave_sum(s) * (1.f / DM) + EPS);
                if (lane == 0) rstd_l[wave * 16 + q + u] = rstd;
                unsigned* o4 = (unsigned*)((unsigned char*)a.h2 + (size_t)t * F8P) + lane; u32x2* o8 = (u32x2*)((bf16*)a.h2 + (size_t)t * DM) + lane;
#pragma unroll
                for (int j = 0; j < 4; ++j) { const f32x4 g = gr[64 * j]; const f32x4 y = v[u][j] * rstd * g;
                    if (MOE_F8) o4[64 * j] = cvt4_fp8(y[0], y[1], y[2], y[3]); else { u32x2 w; w.x = cvt_pk_bf16(y[0], y[1]); w.y = cvt_pk_bf16(y[2], y[3]); o8[64 * j] = w; } } }
        }
        LDS_WAIT(); asm volatile("" ::: "memory");
        const int r = lane & 15, g = lane >> 4;
        const float rs = rstd_l[wave * 16 + r];
        const float* xrow = a.x1 + (size_t)(base + 16 * wave + r) * DM + 8 * g;
        const float* grow = a.norm_ffn + 8 * g;
        const LAS unsigned char* wl = lds + r * 2048; const int sw = r << 4, g16 = 16 * g;
        f32x4 acc0 = (f32x4){0.f, 0.f, 0.f, 0.f}, acc1 = (f32x4){0.f, 0.f, 0.f, 0.f};
#define P6_LD(S, off) f32x4 xa##S = *(const f32x4*)(xrow + (off)), xb##S = *(const f32x4*)(xrow + (off) + 4), ga##S = *(const f32x4*)(grow + (off)), gb##S = *(const f32x4*)(grow + (off) + 4); \
        bf16x8 h##S##0 = *(const LAS bf16x8*)(wl + (((off) * 2 + g16) ^ sw)), h##S##1 = *(const LAS bf16x8*)(wl + 32768 + (((off) * 2 + g16) ^ sw)), l##S##0 = *(const LAS bf16x8*)(wl + 65536 + (((off) * 2 + g16) ^ sw)), l##S##1 = *(const LAS bf16x8*)(wl + 98304 + (((off) * 2 + g16) ^ sw));
#define P6_RL(S, off) xa##S = *(const f32x4*)(xrow + (off)); xb##S = *(const f32x4*)(xrow + (off) + 4); ga##S = *(const f32x4*)(grow + (off)); gb##S = *(const f32x4*)(grow + (off) + 4); \
        h##S##0 = *(const LAS bf16x8*)(wl + (((off) * 2 + g16) ^ sw)); h##S##1 = *(const LAS bf16x8*)(wl + 32768 + (((off) * 2 + g16) ^ sw)); l##S##0 = *(const LAS bf16x8*)(wl + 65536 + (((off) * 2 + g16) ^ sw)); l##S##1 = *(const LAS bf16x8*)(wl + 98304 + (((off) * 2 + g16) ^ sw));
        P6_LD(0, 0) P6_LD(1, 32) P6_LD(2, 64) P6_LD(3, 96)
#define P6_MMA(XA, XB, GA, GB, H0, H1, L0, L1) { bf16x8 ahi, alo; p6_split8(XA, XB, GA, GB, rs, ahi, alo); \
            acc0 = __builtin_amdgcn_mfma_f32_16x16x32_bf16(ahi, H0, acc0, 0, 0, 0); acc0 = __builtin_amdgcn_mfma_f32_16x16x32_bf16(alo, H0, acc0, 0, 0, 0); acc0 = __builtin_amdgcn_mfma_f32_16x16x32_bf16(ahi, L0, acc0, 0, 0, 0); \
            acc1 = __builtin_amdgcn_mfma_f32_16x16x32_bf16(ahi, H1, acc1, 0, 0, 0); acc1 = __builtin_amdgcn_mfma_f32_16x16x32_bf16(alo, H1, acc1, 0, 0, 0); acc1 = __builtin_amdgcn_mfma_f32_16x16x32_bf16(ahi, L1, acc1, 0, 0, 0); }
#pragma unroll 1
        for (int ks = 0; ks < 32; ks += 4) {
            const int nx = (ks + 4 < 32) ? 32 * (ks + 4) : 0;
            P6_MMA(xa0, xb0, ga0, gb0, h00, h01, l00, l01) P6_RL(0, nx)
            P6_MMA(xa1, xb1, ga1, gb1, h10, h11, l10, l11) P6_RL(1, nx + 32)
            P6_MMA(xa2, xb2, ga2, gb2, h20, h21, l20, l21) P6_RL(2, nx + 64)
            P6_MMA(xa3, xb3, ga3, gb3, h30, h31, l30, l31) P6_RL(3, nx + 96)
        }
#undef P6_LD
#undef P6_RL
#undef P6_MMA
        { const float b0 = a.b_router[r], b1 = a.b_router[16 + r];
#pragma unroll
          for (int i = 0; i < 4; ++i) {
              float c0 = acc0[i] + b0, c1 = acc1[i] + b1;
              float tv[4]; int te[4];
#pragma unroll
              for (int k = 0; k < 4; ++k) {
                  float bv; int be; if (c1 > c0) { bv = c1; be = 16 + r; } else { bv = c0; be = r; }
#pragma unroll
                  for (int o = 1; o < 16; o <<= 1) { const float ov = __shfl_xor(bv, o); const int oe = __shfl_xor(be, o); if (ov > bv || (ov == bv && oe < be)) { bv = ov; be = oe; } }
                  tv[k] = bv; te[k] = be; if (be == r) c0 = -INFINITY; if (be == 16 + r) c1 = -INFINITY; }
              const float e1 = __expf(tv[1] - tv[0]), e2 = __expf(tv[2] - tv[0]), e3 = __expf(tv[3] - tv[0]); const float inv = 1.f / (1.f + e1 + e2 + e3);
              if (r < 4) { const int ee = r == 0 ? te[0] : r == 1 ? te[1] : r == 2 ? te[2] : te[3]; const float gg = (r == 0 ? 1.f : r == 1 ? e1 : r == 2 ? e2 : e3) * inv;
                  const unsigned lr = __hip_atomic_fetch_add(&lcnt[ee], 1u, __ATOMIC_RELAXED, __HIP_MEMORY_SCOPE_WORKGROUP); const int ri = 16 * wave + 4 * g + i; lsel[ri * 4 + r] = (unsigned)ee | (lr << 8); lgate[ri * 4 + r] = gg; }
          } }
        __syncthreads();
        if (tid < 32) lbase[tid] = __hip_atomic_fetch_add(a.cnt + 16 * tid, lcnt[tid], __ATOMIC_RELAXED, __HIP_MEMORY_SCOPE_AGENT);
        __syncthreads();
        for (int i = tid; i < rows_per * 4; i += 512) { const unsigned s = lsel[i]; const int e = s & 255; const unsigned pos = lbase[e] + (s >> 8); const int t = base + (i >> 2);
            a.toki[(size_t)t * 4 + (i & 3)] = (u32x2){(unsigned)e | (pos << 8), __float_as_uint(lgate[i])}; a.tokl[(size_t)e * T + pos] = t; }
        __syncthreads();
    }
}

__device__ __forceinline__ void p9_final(float* out, float* dst, const bf16* yexp, const u32x2* toki, const unsigned* cnt, const float* norm_final, LAS unsigned char* lds, int tid, int wave, int lane, int vcu, int G) {
    LAS int* pst = (LAS int*)lds;
    if (tid == 0) { int acc = 0; for (int e = 0; e < NEXP; ++e) { pst[e] = acc; acc += ((int)cnt[16 * e] + 255) / 256 * 256; } }
    __syncthreads();
    const int gw = vcu * 8 + wave, NGW = G * 8;
    for (int t0 = gw; t0 < T; t0 += 2 * NGW) {
        const int t1 = (t0 + NGW < T) ? t0 + NGW : t0;
        const f32x4* gr = (const f32x4*)norm_final + lane;
        u32x4 ta[2], tb[2];
#pragma unroll
        for (int u = 0; u < 2; ++u) { const u32x4* tp = (const u32x4*)(toki + (size_t)(u ? t1 : t0) * 4); ta[u] = tp[0]; tb[u] = tp[1]; }
        u32x2 yv[2][4][4]; f32x4 v[2][4];
#pragma unroll
        for (int u = 0; u < 2; ++u) { const int t = u ? t1 : t0; const unsigned ti[4] = {ta[u].x, ta[u].z, tb[u].x, tb[u].z};
#pragma unroll
            for (int k = 0; k < 4; ++k) { const int e = ti[k] & 255; const int pos = ti[k] >> 8; const u32x2* yr = (const u32x2*)(yexp + (size_t)(pst[e] + pos) * DM) + lane;
#pragma unroll
                for (int j = 0; j < 4; ++j) yv[u][k][j] = yr[64 * j]; }
            const f32x4* xr = (const f32x4*)(out + (size_t)t * DM) + lane;
#pragma unroll
            for (int j = 0; j < 4; ++j) v[u][j] = xr[64 * j]; }
#pragma unroll
        for (int u = 0; u < 2; ++u) { const int t = u ? t1 : t0; if (u == 1 && t1 == t0) break;
            const float tg[4] = {__uint_as_float(ta[u].y), __uint_as_float(ta[u].w), __uint_as_float(tb[u].y), __uint_as_float(tb[u].w)};
#pragma unroll
            for (int k = 0; k < 4; ++k) { const float g = tg[k];
#pragma unroll
                for (int j = 0; j < 4; ++j) { const u32x2 w = yv[u][k][j]; v[u][j][0] += g * bflo(w.x); v[u][j][1] += g * bfhi(w.x); v[u][j][2] += g * bflo(w.y); v[u][j][3] += g * bfhi(w.y); } }
            float s = 0.f;
#pragma unroll
            for (int j = 0; j < 4; ++j) s += (v[u][j][0] * v[u][j][0] + v[u][j][1] * v[u][j][1]) + (v[u][j][2] * v[u][j][2] + v[u][j][3] * v[u][j][3]);
            const float rstd = rsqrtf(wave_sum(s) * (1.f / DM) + EPS);
            f32x4* dr = (f32x4*)(dst + (size_t)t * DM) + lane;
#pragma unroll
            for (int j = 0; j < 4; ++j) { const f32x4 g = gr[64 * j]; dr[64 * j] = v[u][j] * rstd * g; } }
    }
}
#define HAVE_MIX 1
struct MixArgs { const bf16* PROJ; const bf16* VT; unsigned short* MASKQ; bf16* YA; bf16* YB; float* HU; float* HD; const float* hgrn_norm; const float* lb_logits; const float* rel_bias; };
__device__ const unsigned char T5BUCKET[129] = {0, 1, 2, 3, 4, 5, 6, 7, 8, 9, 10, 11, 12, 13, 14, 15, 16, 16, 16, 17, 17, 18, 18, 18, 19, 19, 19, 20, 20, 20, 20, 21, 21, 21, 21, 22, 22, 22, 22, 22, 23, 23, 23, 23, 23, 23, 24, 24, 24, 24, 24, 24, 25, 25, 25, 25, 25, 25, 25, 26, 26, 26, 26, 26, 26, 26, 26, 27, 27, 27, 27, 27, 27, 27, 27, 27, 27, 28, 28, 28, 28, 28, 28, 28, 28, 28, 28, 29, 29, 29, 29, 29, 29, 29, 29, 29, 29, 29, 29, 30, 30, 30, 30, 30, 30, 30, 30, 30, 30, 30, 30, 30, 30, 31, 31, 31, 31, 31, 31, 31, 31, 31, 31, 31, 31, 31, 31, 31, 31};
constexpr float LOG2E = 1.4426950408889634f;
__device__ __forceinline__ bf16x8 pack8(float a0, float a1, float a2, float a3, float a4, float a5, float a6, float a7) {
    u32x4 w; w.x = cvt_pk_bf16(a0, a1); w.y = cvt_pk_bf16(a2, a3); w.z = cvt_pk_bf16(a4, a5); w.w = cvt_pk_bf16(a6, a7); return __builtin_bit_cast(bf16x8, w);
}
__device__ __forceinline__ bf16x8 lo4(u32x2 v) { u32x4 w; w.x = v.x; w.y = v.y; w.z = 0u; w.w = 0u; return __builtin_bit_cast(bf16x8, w); }

__device__ __forceinline__ void pidx_unit(const MixArgs& m, LAS unsigned char* lds, int tid, int wave, int lane, int b, int qt) {
    LAS unsigned* hist = (LAS unsigned*)lds;
    LAS unsigned* s_pfx = (LAS unsigned*)(lds + 16512);
    LAS unsigned* s_k2 = (LAS unsigned*)(lds + 16640);
    LAS unsigned* s_krem = (LAS unsigned*)(lds + 16768);
    LAS unsigned* kbq = (LAS unsigned*)(lds + 16896);
    LAS unsigned* s_unres = (LAS unsigned*)(lds + 25088);
    const int c = lane & 15, g = lane >> 4;
    const size_t rowq = (size_t)b * SEQ + (size_t)qt * 16;
    const bf16* PROJ = m.PROJ;
    for (int i = tid; i < 16 * 257; i += 512) hist[i] = 0u;
    for (int i = tid; i < 16 * 128; i += 512) kbq[i] = 0u;
    if (tid < 16) { s_pfx[tid] = 0u; s_k2[tid] = 0u; const int nv = qt * 16 + tid + 1; s_krem[tid] = (unsigned)(nv < 256 ? nv : 256); if (tid < 6) s_unres[tid] = 0u; }
    __syncthreads();
    const float WS = 0.35355339059327373f * 0.17677669529663687f * 0.5f;
    bf16x8 qf[8];
#pragma unroll
    for (int h = 0; h < 8; ++h) qf[h] = *(const bf16x8*)(PROJ + (rowq + c) * NPJ + C_IQ + h * 32 + 8 * g);
    bf16x8 ql; float wq[8];
    { const u32x4 wr = *(const u32x4*)(PROJ + (rowq + c) * NPJ + C_IW);
      wq[0] = bflo(wr.x) * WS; wq[1] = bfhi(wr.x) * WS; wq[2] = bflo(wr.y) * WS; wq[3] = bfhi(wr.y) * WS; wq[4] = bflo(wr.z) * WS; wq[5] = bfhi(wr.z) * WS; wq[6] = bflo(wr.w) * WS; wq[7] = bfhi(wr.w) * WS;
      float a[8];
#pragma unroll
      for (int j = 0; j < 8; ++j) { a[j] = 0.f;
#pragma unroll
          for (int h = 0; h < 8; ++h) a[j] += wq[h] * bf2f((unsigned short)qf[h][j]); }
      ql = pack8(a[0], a[1], a[2], a[3], a[4], a[5], a[6], a[7]); }
    const int ngrp = qt / 4 + 1, tq = qt * 16 + c;
    unsigned sc[8][4][4];
    const bf16* kbase = PROJ + ((size_t)b * SEQ + c) * NPJ + C_IK + 8 * g;
    bf16x8 kn[4];
#pragma unroll
    for (int j = 0; j < 4; ++j) kn[j] = (wave < ngrp) ? *(const bf16x8*)(kbase + (size_t)((wave * 4 + j) * 16) * NPJ) : (bf16x8){0, 0, 0, 0, 0, 0, 0, 0};
#pragma unroll
    for (int slot = 0; slot < 8; ++slot) {
        const int g64 = slot * 8 + wave;
        bf16x8 kc[4];
#pragma unroll
        for (int j = 0; j < 4; ++j) kc[j] = kn[j];
        if (slot < 7 && g64 + 8 < ngrp) {
#pragma unroll
            for (int j = 0; j < 4; ++j) kn[j] = *(const bf16x8*)(kbase + (size_t)(((g64 + 8) * 4 + j) * 16) * NPJ);
        }
        if (g64 < ngrp) {
#pragma unroll
            for (int j = 0; j < 4; ++j) { const int key0 = (g64 * 4 + j) * 16;
                const bf16x8 kf = kc[j];
                f32x4 acc = __builtin_amdgcn_mfma_f32_16x16x32_bf16(kf, ql, (f32x4){0.f, 0.f, 0.f, 0.f}, 0, 0, 0);
#pragma unroll
                for (int h = 0; h < 8; ++h) { const f32x4 d = __builtin_amdgcn_mfma_f32_16x16x32_bf16(kf, qf[h], (f32x4){0.f, 0.f, 0.f, 0.f}, 0, 0, 0);
#pragma unroll
                    for (int i = 0; i < 4; ++i) acc[i] += wq[h] * __builtin_fabsf(d[i]); }
#pragma unroll
                for (int i = 0; i < 4; ++i) { const bool valid = key0 + 4 * g + i <= tq; const unsigned bits = __float_as_uint(acc[i]); const unsigned u = bits ^ ((unsigned)((int)bits >> 31) | 0x80000000u); sc[slot][j][i] = valid ? u : 0u;
                    if (valid) (void)__hip_atomic_fetch_add(&hist[c * 257 + (u >> 24)], 1u, __ATOMIC_RELAXED, __HIP_MEMORY_SCOPE_WORKGROUP); } }
        } else {
#pragma unroll
            for (int j = 0; j < 4; ++j)
#pragma unroll
                for (int i = 0; i < 4; ++i) sc[slot][j][i] = 0u;
        }
    }
    __syncthreads();
    bool finished = false; int fb = 0;
#pragma unroll
    for (int p = 0; p < 6; ++p) {
        if (finished) continue;
        const int rb = p & 1, wb = rb ^ 1;
        const unsigned pf = s_pfx[rb * 16 + c], k2p = s_k2[rb * 16 + c];
#pragma unroll
        for (int slot = 0; slot < 8; ++slot) {
            const int g64 = slot * 8 + wave;
            if (g64 < ngrp) {
#pragma unroll
                for (int j = 0; j < 4; ++j)
#pragma unroll
                    for (int i = 0; i < 4; ++i) { const unsigned u = sc[slot][j][i]; const unsigned key2 = 4095u - (unsigned)((g64 * 4 + j) * 16 + 4 * g + i);
                        bool part; unsigned bin;
                        if (p == 0) { part = false; bin = 0u; }
                        else if (p < 4) { const int sh = 24 - 8 * p; part = (u != 0u) && ((u >> (sh + 8)) == (pf >> (sh + 8))); bin = (u >> sh) & 255u; }
                        else if (p == 4) { part = (u != 0u) && (u == pf); bin = key2 >> 4; }
                        else { part = (u != 0u) && (u == pf) && ((key2 >> 4) == (k2p >> 4)); bin = key2 & 15u; }
                        if (part) (void)__hip_atomic_fetch_add(&hist[c * 257 + bin], 1u, __ATOMIC_RELAXED, __HIP_MEMORY_SCOPE_WORKGROUP); }
            }
        }
        __syncthreads();
        { const int qq = tid >> 5, jj = tid & 31; const unsigned krem = s_krem[rb * 16 + qq];
          unsigned h8[8]; unsigned csum = 0u;
#pragma unroll
          for (int k = 0; k < 8; ++k) { h8[k] = hist[qq * 257 + 255 - 8 * jj - k]; csum += h8[k]; }
          unsigned incl = csum;
#pragma unroll
          for (int o = 1; o < 32; o <<= 1) { const unsigned v = __shfl_up(incl, o, 32); if (jj >= o) incl += v; }
          const unsigned excl = incl - csum;
          if (excl < krem && krem <= incl) { unsigned run = excl, bin = 0u, newk = 0u, hsel = 0u; bool done = false;
#pragma unroll
              for (int k = 0; k < 8; ++k) { if (!done) { if (run + h8[k] >= krem) { bin = (unsigned)(255 - 8 * jj - k); newk = krem - run; hsel = h8[k]; done = true; } else run += h8[k]; } }
              if (hsel != newk) s_unres[p] = 1u;
              const unsigned op = s_pfx[rb * 16 + qq], ok2 = s_k2[rb * 16 + qq];
              if (p < 4) { s_pfx[wb * 16 + qq] = op | (bin << (24 - 8 * (p < 4 ? p : 0))); s_k2[wb * 16 + qq] = 0u; }
              else if (p == 4) { s_pfx[wb * 16 + qq] = op; s_k2[wb * 16 + qq] = bin << 4; }
              else { s_pfx[wb * 16 + qq] = op; s_k2[wb * 16 + qq] = ok2 | bin; }
              s_krem[wb * 16 + qq] = newk; }
#pragma unroll
          for (int k = 0; k < 8; ++k) hist[qq * 257 + 255 - 8 * jj - k] = 0u;
        }
        __syncthreads();
        fb = wb; finished = (s_unres[p] == 0u);
    }
    { const unsigned thr = s_pfx[fb * 16 + c], tk2 = s_k2[fb * 16 + c];
#pragma unroll
      for (int slot = 0; slot < 8; ++slot) {
          const int g64 = slot * 8 + wave;
          if (g64 < ngrp) {
#pragma unroll
              for (int j = 0; j < 4; ++j)
#pragma unroll
                  for (int i = 0; i < 4; ++i) { const unsigned u = sc[slot][j][i]; const int key = (g64 * 4 + j) * 16 + 4 * g + i; const unsigned key2 = 4095u - (unsigned)key;
                      const bool sel = (u > thr) || (u == thr && u != 0u && key2 >= tk2);
                      if (sel) (void)__hip_atomic_fetch_or(&kbq[c * 128 + (key >> 5)], 1u << (key & 31), __ATOMIC_RELAXED, __HIP_MEMORY_SCOPE_WORKGROUP); }
          }
      }
    }
    __syncthreads();
    for (int idx = tid; idx < 16 * ngrp; idx += 512) { const int qq = idx & 15, gg = idx >> 4;
        *(u32x2*)(m.MASKQ + (rowq + qq) * 256 + 4 * gg) = *(const LAS u32x2*)(kbq + qq * 128 + 2 * gg); }
    __syncthreads();
}

__device__ __forceinline__ void attn_unit(const MixArgs& m, LAS unsigned char* lds, int tid, int wave, int lane, int b, int h, int qb) {
    LAS bf16* Ks = (LAS bf16*)lds;
    LAS bf16* Vs = (LAS bf16*)(lds + 18432);
    LAS float* btab = (LAS float*)(lds + 36864);
    const int r32 = lane & 31, hi = lane >> 5;
    if (tid < 129) btab[tid] = m.rel_bias[(int)T5BUCKET[tid] * 8 + h] * LOG2E;
    const float bfar = m.rel_bias[31 * 8 + h] * LOG2E;
    const float C2 = 0.125f * LOG2E;
    const int q0w = qb * 256 + 32 * wave;
    const size_t rowq = (size_t)b * SEQ + q0w + r32;
    bf16x8 qf[4];
#pragma unroll
    for (int ds = 0; ds < 4; ++ds) qf[ds] = *(const bf16x8*)(m.PROJ + rowq * NPJ + C_AQ + h * 64 + 16 * ds + 8 * hi);
    const int NT = 4 * qb + 4, tw = 4 * qb + (wave >> 1);
    const int srow = tid >> 3, sch = tid & 7;
    const bf16* kptr = m.PROJ + ((size_t)b * SEQ + srow) * NPJ + C_AK + h * 64 + 8 * sch;
    const bf16* vptr = m.VT + (size_t)(h * 64 + srow) * T + (size_t)b * SEQ + 8 * sch;
    u32x4 kr = *(const u32x4*)kptr, vr = *(const u32x4*)vptr;
    *(LAS u32x4*)(Ks + srow * 72 + 8 * sch) = kr; *(LAS u32x4*)(Vs + srow * 72 + 8 * sch) = vr;
    __syncthreads();
    float m_run = -INFINITY, l_run = 0.f; f32x16 o[2];
#pragma unroll
    for (int r = 0; r < 16; ++r) { o[0][r] = 0.f; o[1][r] = 0.f; }
    const unsigned long long* mrow = (const unsigned long long*)(m.MASKQ + rowq * 256);
    for (int t = 0; t < NT; ++t) {
        const int buf = t & 1;
        if (t + 1 < NT) { kr = *(const u32x4*)(kptr + (size_t)(t + 1) * 64 * NPJ); vr = *(const u32x4*)(vptr + (t + 1) * 64); }
        if (t <= tw) {
            const unsigned long long mw = mrow[t] >> (4 * hi);
            const unsigned mlo = (unsigned)mw, mhi = (unsigned)(mw >> 32);
            f32x16 p[2];
#pragma unroll
            for (int hh = 0; hh < 2; ++hh) {
#pragma unroll
                for (int r = 0; r < 16; ++r) p[hh][r] = 0.f;
#pragma unroll
                for (int ds = 0; ds < 4; ++ds) { const bf16x8 kf = *(const LAS bf16x8*)(Ks + buf * 4608 + (32 * hh + r32) * 72 + 16 * ds + 8 * hi);
                    p[hh] = __builtin_amdgcn_mfma_f32_32x32x16_bf16(kf, qf[ds], p[hh], 0, 0, 0); }
            }
            const bool near = (q0w - (64 * t + 63)) < 128;
            float mx = -INFINITY;
#pragma unroll
            for (int hh = 0; hh < 2; ++hh) { const int dbase = q0w + r32 - (64 * t + 32 * hh + 4 * hi); const unsigned mword = hh ? mhi : mlo;
#pragma unroll
                for (int r = 0; r < 16; ++r) { const int cpos = (r & 3) + 8 * (r >> 2);
                    float bias = bfar;
                    if (near) { int dd = dbase - cpos; dd = dd < 0 ? 0 : (dd > 128 ? 128 : dd); bias = btab[dd]; }
                    float s = p[hh][r] * C2 + bias; s = ((mword >> cpos) & 1u) ? s : -INFINITY; p[hh][r] = s; mx = fmaxf(mx, s); } }
            mx = fmaxf(mx, __shfl_xor(mx, 32));
            const float m_new = fmaxf(m_run, mx); const float msafe = (m_new == -INFINITY) ? 0.f : m_new;
            const float alpha = __builtin_amdgcn_exp2f(m_run - msafe); m_run = m_new;
            float rs = 0.f;
#pragma unroll
            for (int hh = 0; hh < 2; ++hh)
#pragma unroll
                for (int r = 0; r < 16; ++r) { const float e = __builtin_amdgcn_exp2f(p[hh][r] - msafe); p[hh][r] = e; rs += e; }
            l_run = l_run * alpha + rs;
#pragma unroll
            for (int r = 0; r < 16; ++r) { o[0][r] *= alpha; o[1][r] *= alpha; }
#pragma unroll
            for (int ks = 0; ks < 4; ++ks) { const int hh = ks >> 1, s2 = ks & 1;
                const bf16x8 pb = pack8(p[hh][8 * s2 + 0], p[hh][8 * s2 + 1], p[hh][8 * s2 + 2], p[hh][8 * s2 + 3], p[hh][8 * s2 + 4], p[hh][8 * s2 + 5], p[hh][8 * s2 + 6], p[hh][8 * s2 + 7]);
#pragma unroll
                for (int dh = 0; dh < 2; ++dh) { const LAS bf16* vp = Vs + buf * 4608 + (32 * dh + r32) * 72 + 32 * hh + 16 * s2 + 4 * hi;
                    const u32x2 v0 = *(const LAS u32x2*)vp, v1 = *(const LAS u32x2*)(vp + 8);
                    u32x4 vw; vw.x = v0.x; vw.y = v0.y; vw.z = v1.x; vw.w = v1.y;
                    o[dh] = __builtin_amdgcn_mfma_f32_32x32x16_bf16(__builtin_bit_cast(bf16x8, vw), pb, o[dh], 0, 0, 0); } }
        }
        if (t + 1 < NT) { *(LAS u32x4*)(Ks + (buf ^ 1) * 4608 + srow * 72 + 8 * sch) = kr; *(LAS u32x4*)(Vs + (buf ^ 1) * 4608 + srow * 72 + 8 * sch) = vr; }
        __syncthreads();
    }
    const float lt = l_run + __shfl_xor(l_run, 32); const float inv = 1.0f / lt;
    bf16* orow = m.YA + rowq * 1024 + h * 64;
#pragma unroll
    for (int dh = 0; dh < 2; ++dh)
#pragma unroll
        for (int a = 0; a < 4; ++a) { u32x2 w; w.x = cvt_pk_bf16(o[dh][4 * a] * inv, o[dh][4 * a + 1] * inv); w.y = cvt_pk_bf16(o[dh][4 * a + 2] * inv, o[dh][4 * a + 3] * inv);
            *(u32x2*)(orow + 32 * dh + 8 * a + 4 * hi) = w; }
    __syncthreads();
}

template <bool OUT> __device__ __forceinline__ void hgrn_unit(const MixArgs& m, LAS unsigned char* lds, int tid, int wave, int lane, int b, int h, int c) {
    LAS bf16* QT = (LAS bf16*)lds;
    LAS bf16* KH = (LAS bf16*)(lds + 4352);
    LAS bf16* KT = (LAS bf16*)(lds + 8704);
    LAS bf16* VTL = (LAS bf16*)(lds + 12800);
    LAS float* DEC = (LAS float*)(lds + 16896);
    LAS float* PART = (LAS float*)(lds + 17408);
    LAS float* OBUF = (LAS float*)(lds + 19456);
    const bf16* PROJ = m.PROJ;
    const int d = tid & 127, tq = tid >> 7;
    const int c16 = lane & 15, g = lane >> 4;
    const int bh = b * 4 + h;
    const float lbv = sigmoidf_(m.lb_logits[h * 128 + d] - m.lb_logits[512 + h * 128 + d]);
    float Btot = 1.f;
    f32x4 st[8];
#pragma unroll
    for (int dt = 0; dt < 8; ++dt) st[dt] = (f32x4){0.f, 0.f, 0.f, 0.f};
    if (OUT) {
        const int e = 16 * wave + c16;
        for (int j = 0; j < c; ++j) { const float* U = m.HU + (size_t)(bh * 16 + j) * 16384; const float* Dj = m.HD + (size_t)(bh * 16 + j) * 128;
#pragma unroll
            for (int dt = 0; dt < 8; ++dt) { const f32x4 dv = *(const f32x4*)(Dj + 16 * dt + 4 * g);
#pragma unroll
                for (int i = 0; i < 4; ++i) st[dt][i] = dv[i] * st[dt][i] + U[(size_t)(16 * dt + 4 * g + i) * 128 + e]; } }
    }
    unsigned short rf[4], rq[4], rv[4], nf[4], nq[4], nv[4];
    { const size_t row0 = (size_t)b * SEQ + (size_t)c * 256;
#pragma unroll
      for (int k = 0; k < 4; ++k) { const bf16* pr = PROJ + (row0 + 4 * tq + k) * NPJ + h * 128 + d; rf[k] = pr[C_BF]; rq[k] = pr[C_BQ]; rv[k] = pr[C_BI]; } }
    for (int s16 = 0; s16 < 16; ++s16) {
        const size_t row0 = (size_t)b * SEQ + (size_t)c * 256 + s16 * 16;
        if (s16 < 15) {
#pragma unroll
            for (int k = 0; k < 4; ++k) { const bf16* pr = PROJ + (row0 + 16 + 4 * tq + k) * NPJ + h * 128 + d; nf[k] = pr[C_BF]; nq[k] = pr[C_BQ]; nv[k] = pr[C_BI]; } }
        unsigned short pg0[2], pg1[2];
        if (OUT) {
#pragma unroll
            for (int q = 0; q < 2; ++q) { const bf16* pg = PROJ + (row0 + 2 * wave + q) * NPJ + C_BG + h * 128; pg0[q] = pg[lane]; pg1[q] = pg[64 + lane]; } }
        float kk[4], qs[4], cum[4]; unsigned short vraw[4];
#pragma unroll
        for (int k = 0; k < 4; ++k) {
            const float fr = bf2f(rf[k]), qr = bf2f(rq[k]); vraw[k] = rv[k];
            const float f = lbv + (1.f - lbv) * sigmoidf_(fr); cum[k] = (k == 0) ? f : cum[k - 1] * f; kk[k] = 1.f - f; qs[k] = qr * sigmoidf_(qr) * 0.08838834764831845f; }
        PART[tq * 128 + d] = cum[3];
        { u32x2 w; w.x = (unsigned)vraw[0] | ((unsigned)vraw[1] << 16); w.y = (unsigned)vraw[2] | ((unsigned)vraw[3] << 16); *(LAS u32x2*)(VTL + d * 16 + 4 * tq) = w; }
        __syncthreads();
        float off = 1.f, tot = 1.f;
#pragma unroll
        for (int q = 0; q < 4; ++q) { const float pv = PART[q * 128 + d]; tot *= pv; if (q < tq) off *= pv; }
        float kt4[4];
#pragma unroll
        for (int k = 0; k < 4; ++k) { const float Pt = off * cum[k]; const float rP = __builtin_amdgcn_rcpf(Pt); const int tt = 4 * tq + k;
            QT[tt * 136 + d] = (bf16)(cvt_pk_bf16(qs[k] * Pt, 0.f) & 0xffffu);
            KH[tt * 136 + d] = (bf16)(cvt_pk_bf16(kk[k] * rP, 0.f) & 0xffffu);
            kt4[k] = kk[k] * (tot * rP); }
        { u32x2 w; w.x = cvt_pk_bf16(kt4[0], kt4[1]); w.y = cvt_pk_bf16(kt4[2], kt4[3]); *(LAS u32x2*)(KT + d * 16 + 4 * tq) = w; }
        if (tq == 0) { DEC[d] = tot; Btot *= tot; }
        __syncthreads();
        const bf16x8 bv = lo4(*(const LAS u32x2*)(VTL + (16 * wave + c16) * 16 + 4 * g));
        if (OUT) {
            f32x4 acc = (f32x4){0.f, 0.f, 0.f, 0.f}, aT = (f32x4){0.f, 0.f, 0.f, 0.f};
#pragma unroll
            for (int ks = 0; ks < 4; ++ks) {
                const u32x2 a0 = *(const LAS u32x2*)(QT + c16 * 136 + 32 * ks + 4 * g), a1 = *(const LAS u32x2*)(QT + c16 * 136 + 32 * ks + 16 + 4 * g);
                u32x4 aw; aw.x = a0.x; aw.y = a0.y; aw.z = a1.x; aw.w = a1.y;
                const bf16x8 sb = pack8(st[2 * ks][0], st[2 * ks][1], st[2 * ks][2], st[2 * ks][3], st[2 * ks + 1][0], st[2 * ks + 1][1], st[2 * ks + 1][2], st[2 * ks + 1][3]);
                acc = __builtin_amdgcn_mfma_f32_16x16x32_bf16(__builtin_bit_cast(bf16x8, aw), sb, acc, 0, 0, 0);
                const bf16x8 kh = *(const LAS bf16x8*)(KH + c16 * 136 + 32 * ks + 8 * g), qn = *(const LAS bf16x8*)(QT + c16 * 136 + 32 * ks + 8 * g);
                aT = __builtin_amdgcn_mfma_f32_16x16x32_bf16(kh, qn, aT, 0, 0, 0);
            }
#pragma unroll
            for (int i = 0; i < 4; ++i) if (4 * g + i > c16) aT[i] = 0.f;
            const bf16x8 aa = pack8(aT[0], aT[1], aT[2], aT[3], 0.f, 0.f, 0.f, 0.f);
            acc = __builtin_amdgcn_mfma_f32_16x16x32_bf16(aa, bv, acc, 0, 0, 0);
#pragma unroll
            for (int i = 0; i < 4; ++i) OBUF[(4 * g + i) * 132 + 16 * wave + c16] = acc[i];
        }
#pragma unroll
        for (int dt = 0; dt < 8; ++dt) { const bf16x8 ka = lo4(*(const LAS u32x2*)(KT + (16 * dt + c16) * 16 + 4 * g)); const f32x4 dv = *(const LAS f32x4*)(DEC + 16 * dt + 4 * g);
            st[dt] = __builtin_amdgcn_mfma_f32_16x16x32_bf16(ka, bv, st[dt] * dv, 0, 0, 0); }
        __syncthreads();
        if (OUT) {
#pragma unroll
            for (int q = 0; q < 2; ++q) { const int t = 2 * wave + q; const float o0 = OBUF[t * 132 + lane], o1 = OBUF[t * 132 + 64 + lane];
                const float rstd = rsqrtf(wave_sum(o0 * o0 + o1 * o1) * (1.f / 128.f) + EPS);
                const float g0 = bf2f(pg0[q]), g1 = bf2f(pg1[q]);
                const float y0 = o0 * rstd * m.hgrn_norm[h * 128 + lane] * g0 * sigmoidf_(g0), y1 = o1 * rstd * m.hgrn_norm[h * 128 + 64 + lane] * g1 * sigmoidf_(g1);
                bf16* yo = m.YB + (row0 + t) * 1024 + h * 128;
                yo[lane] = (bf16)(cvt_pk_bf16(y0, 0.f) & 0xffffu); yo[64 + lane] = (bf16)(cvt_pk_bf16(y1, 0.f) & 0xffffu); }
        }
#pragma unroll
        for (int k = 0; k < 4; ++k) { rf[k] = nf[k]; rq[k] = nq[k]; rv[k] = nv[k]; }
    }
    if (!OUT) {
        const int e = 16 * wave + c16; float* U = m.HU + (size_t)(bh * 16 + c) * 16384;
#pragma unroll
        for (int dt = 0; dt < 8; ++dt)
#pragma unroll
            for (int i = 0; i < 4; ++i) U[(size_t)(16 * dt + 4 * g + i) * 128 + e] = st[dt][i];
        if (tq == 0) m.HD[(size_t)(bh * 16 + c) * 128 + d] = Btot;
    }
    __syncthreads();
}

__device__ __forceinline__ MixArgs make_mix(const Args& args) {
    unsigned char* ws = args.ws;
    return MixArgs{(const bf16*)(ws + WS_PROJ), (const bf16*)(ws + WS_VT), (unsigned short*)(ws + WS_MASK), (bf16*)(ws + WS_YA), (bf16*)(ws + WS_YA) + 512, (float*)(ws + WS_HU), (float*)(ws + WS_HD), args.in[8], args.in[9], args.in[10]};
}
__device__ __forceinline__ void p2_phase(const Args& args, LAS unsigned char* lds, int tid, int wave, int lane, int bx, int G) {
    const MixArgs m = make_mix(args);
    if (args.sub & 1) {
#define PIDX_ROUND(r) { const int k = ((r) & 1) ? (G - 1 - bx) : bx; const int u = (r) * G + k; if (u < 2048) pidx_unit(m, lds, tid, wave, lane, u & 7, 255 - (u >> 3)); }
    PIDX_ROUND(0) PIDX_ROUND(1) PIDX_ROUND(2) PIDX_ROUND(3) PIDX_ROUND(4) PIDX_ROUND(5) PIDX_ROUND(6) PIDX_ROUND(7)
#undef PIDX_ROUND
    }
    if (args.sub & 2)
    for (int u = bx; u < 480; u += G) { const int bh = u / 15, c = u % 15; hgrn_unit<false>(m, lds, tid, wave, lane, bh >> 2, bh & 3, c); }
}
__device__ __forceinline__ void p3_phase(const Args& args, LAS unsigned char* lds, int tid, int wave, int lane, int bx, int G) {
    const MixArgs m = make_mix(args);
    int round = 0;
    if (args.sub & 1)
    for (int base = 0; base < 1024; base += G, ++round) { const int k = (round & 1) ? (G - 1 - bx) : bx; const int u = base + k; if (u < 1024) { const int qb = 15 - (u >> 6), bhh = u & 63; attn_unit(m, lds, tid, wave, lane, bhh >> 3, bhh & 7, qb); } }
    if (args.sub & 2)
    for (int u = bx; u < 512; u += G) { const int bh = u >> 4, c = u & 15; hgrn_unit<true>(m, lds, tid, wave, lane, bh >> 2, bh & 3, 15 - c); }
}

__global__ void __launch_bounds__(512, 2) mk_fwd(Args args) {
    extern __shared__ __attribute__((aligned(16))) unsigned char lds_raw[];
    LAS unsigned char* lds = (LAS unsigned char*)lds_raw;
    volatile LAS unsigned* MISC = (volatile LAS unsigned*)(lds + MISC_OFF);
    const int tid = threadIdx.x, lane = tid & 63, wave = __builtin_amdgcn_readfirstlane(tid >> 6);
    const int G = gridDim.x; const int bx = blockIdx.x; const int vcu = (G % 8 == 0) ? (bx % 8) * (G / 8) + bx / 8 : bx;
    unsigned char* ws = args.ws;
    unsigned* ctl = (unsigned*)(ws + WS_CTL);
    for (int u = tid; u < (LDS_BYTES - RING_BYTES) / 4; u += 512) ((LAS unsigned*)(lds + RING_BYTES))[u] = 0u;
    __syncthreads();
    if (tid == 0) { const unsigned xcc = xb_xcc_id(); MISC[12] = xcc; MISC[13] = __hip_atomic_fetch_add(ctl + CW_TICK + 64 * xcc, 1u, __ATOMIC_RELAXED, __HIP_MEMORY_SCOPE_AGENT); }
    XcdBarrier bar; bar.bar = ctl + CW_BAR; bar.x = 0; bar.st = nullptr;
    if (MK_N_LAUNCHES == 1) bar = xcd_barrier_post(ctl + CW_BAR, MISC + 8);
    const int lo = args.ph_lo, hi = args.ph_hi;
#define IN(k) (lo <= (k) && (k) < hi)
#ifdef DBG_TPHASE
#define STAMP(k) do { if (bx == 0 && tid == 0) ((unsigned long long*)(ctl + 2048))[(k)] = __builtin_amdgcn_s_memrealtime(); } while (0)
#else
#define STAMP(k) do { } while (0)
#endif
#define SEAM(k) do { if (IN(k) && IN((k) + 1)) xcd_barrier(bar); STAMP((k) + 1); } while (0)
    STAMP(0);

    bf16* const WIN = (bf16*)(ws + WS_WIN); bf16* const WV = (bf16*)(ws + WS_WV); bf16* const WUA = (bf16*)(ws + WS_WUA); bf16* const WUB = (bf16*)(ws + WS_WUB);
#ifdef WEIGHTS_IN_GLOBALS
    bf16* const WO = (bf16*)(ws + WS_WO); bf16* const WGU = (bf16*)g_wgu8; bf16* const WDN = (bf16*)g_wdn8;
#else
    bf16* const WO = (bf16*)(ws + WS_WO); bf16* const WGU = (bf16*)(ws + WS_WGU); bf16* const WDN = (bf16*)(ws + WS_WDN);
#endif
    bf16* const XN = (bf16*)(ws + WS_XN); bf16* const PROJ = (bf16*)(ws + WS_PROJ); bf16* const VT = (bf16*)(ws + WS_VT);
    bf16* const YA = (bf16*)(ws + WS_YA); bf16* const YB = (bf16*)(ws + WS_YB); bf16* const MRG = (bf16*)(ws + WS_MRG);
    bf16* const ACT = (bf16*)(ws + WS_ACT); bf16* const YEXP = (bf16*)(ws + WS_YEXP);
    int* const TOKL = (int*)(ws + WS_TOKL); u32x2* const TOKI = (u32x2*)(ws + WS_TOKI);
    unsigned* const CNT = ctl + CW_CNT;

    if (IN(0)) {
        P0Args a{args.in[0], args.in[1], args.in[2], args.in[3], args.in[4], args.in[5], args.in[13], args.in[15], args.in[11], ws, (unsigned char*)WGU, (unsigned char*)WDN};
        p0_prologue(a, lds, wave, lane, vcu, G);
    }
    SEAM(0);
    if (IN(1)) {
        { pg8::StaticSched S; S.init(XN, WIN, T, NPJ, DM, G, bx); pg8::EpiBf16 E{PROJ, NPJ, nullptr, 0, 1.f}; pg8::gemm_phase(lds, DM, S, E); }
        { pg8::StaticSched S; S.init(WV, XN, 512, T, DM, G, bx); pg8::EpiBf16 E{VT, T, nullptr, 0, 1.f}; pg8::gemm_phase(lds, DM, S, E); }
    }
    SEAM(1);
    if (IN(2)) {
#ifdef HAVE_MIX
        p2_phase(args, lds, tid, wave, lane, bx, G);
#endif
    }
    SEAM(2);
    if (IN(3)) {
#ifdef HAVE_MIX
        p3_phase(args, lds, tid, wave, lane, bx, G);
#endif
    }
    SEAM(3);
#ifndef DBG_NOMIX
    if (IN(4)) {
        { pg8::StaticSched S; S.init(YA, WUA, T, DM, DM, G, bx); pg8::EpiMerge2 E{PROJ + C_GA, PROJ + C_GB, MRG}; pg8::gemm_phase(lds, DM, S, E); }
    }
#ifndef DBG_NOMIX
    SEAM(4);
#endif
    if (IN(5)) {
        pg8::StaticSched S; S.init(MRG, WO, T, DM, DM, G, bx); pg8::EpiOutRes E{args.in[0], args.out}; pg8::gemm_phase(lds, DM, S, E);
    }
#else
    SEAM(4);
    if (IN(5)) { for (int m = vcu * 8 + wave; m < T; m += G * 8) { const f32x4* xr = (const f32x4*)(args.in[0] + (size_t)m * DM) + lane; f32x4* orow = (f32x4*)(args.out + (size_t)m * DM) + lane;
        for (int j = 0; j < 4; ++j) orow[64 * j] = xr[64 * j]; } }
#endif
    SEAM(5);
    if (IN(6)) {
        P6Args a{args.out, args.in[6], (const bf16*)(ws + WS_WRH), (const bf16*)(ws + WS_WRL), args.in[12], (unsigned char*)XN, CNT, TOKL, TOKI};
        p6_router(a, lds, tid, wave, lane, vcu, G);
    }
    SEAM(6);
    if (IN(7) || IN(8)) {
        LAS int* tstart = (LAS int*)(lds + RING_BYTES + 16);
        if (tid == 0) { int acc = 0; for (int e = 0; e < NEXP; ++e) { tstart[e] = acc; acc += ((int)__hip_atomic_load(CNT + 16 * e, __ATOMIC_RELAXED, __HIP_MEMORY_SCOPE_AGENT) + 255) / 256; } tstart[NEXP] = acc;
            bool ok = (G % 8 == 0); for (int j = 0; j < 8; ++j) ok = ok && (__hip_atomic_load(ctl + CW_TICK + 64 * j, __ATOMIC_RELAXED, __HIP_MEMORY_SCOPE_AGENT) == (unsigned)(G / 8));
            MISC[14] = ok ? MISC[12] * (unsigned)(G / 8) + MISC[13] : (unsigned)bx; }
        __syncthreads();
        const int vb = (int)MISC[14];
#if MOE_F8
#ifdef F8_PROBE
        if (IN(7) && (args.sub & 8)) { f8g::Sched<true> S{(const unsigned char*)XN, (const unsigned char*)WGU, TOKL, (const int*)CNT, tstart, DM, 8, 2 * DFF, G,
#ifdef F8_PROBE_SAME
            vb & ~31
#else
            vb
#endif
            }; f8g::EpiSwiGLU8 E{args.in[14], (unsigned char*)ACT}; f8g::gemm<f8g::EpiSwiGLU8, f8g::Sched<true>, F8_PROBE>(lds, DM, S, E); } else
#endif
        if (IN(7)) { f8g::Sched<true> S{(const unsigned char*)XN, (const unsigned char*)WGU, TOKL, (const int*)CNT, tstart, DM, 8, 2 * DFF, G, vb}; f8g::EpiSwiGLU8 E{args.in[14], (unsigned char*)ACT}; f8g::gemm(lds, DM, S, E); }
        SEAM(7);
        if (IN(8)) { f8g::Sched<false> S{(const unsigned char*)ACT, (const unsigned char*)WDN, TOKL, (const int*)CNT, tstart, DFF, 4, DM, G, vb}; f8g::EpiDown8 E{args.in[16], YEXP}; f8g::gemm(lds, DFF, S, E); }
#else
        if (IN(7)) {
            constexpr int EB = MOE_F8 ? 1 : 2;
            pg8::MoeSched<true> S{(const unsigned char*)XN, (const unsigned char*)WGU, TOKL, (const int*)CNT, tstart, DM * EB, 8, 2 * DFF, G, bx};
            pg8::EpiSwiGLU E{args.in[14], (unsigned char*)ACT, MOE_F8 ? 1.f / 32.f : 1.f}; pg8::gemm_phase<pg8::EpiSwiGLU, pg8::MoeSched<true>, MOE_F8 != 0>(lds, DM, S, E);
        }
        SEAM(7);
        if (IN(8)) {
            constexpr int EB = MOE_F8 ? 1 : 2;
            pg8::MoeSched<false> S{(const unsigned char*)ACT, (const unsigned char*)WDN, TOKL, (const int*)CNT, tstart, DFF * EB, 4, DM, G, bx};
            pg8::EpiBf16 E{YEXP, DM, args.in[16], DM, MOE_F8 ? 1.f / 32.f : 1.f}; pg8::gemm_phase<pg8::EpiBf16, pg8::MoeSched<false>, MOE_F8 != 0>(lds, DFF, S, E);
        }
#endif
    }
    SEAM(8);
    if (IN(9)) p9_final(args.out, (args.sub & 4) ? (float*)(ws + WS_PROJ) : args.out, YEXP, TOKI, CNT, args.in[7], lds, tid, wave, lane, vcu, G);
#ifdef DBG_TPHASE
    __syncthreads(); STAMP(10);
#endif
#undef IN
#undef SEAM
}

#if DBG_STAGE >= 0
__device__ __forceinline__ float block_sum256(float v, float* sh) {
    v = wave_sum(v); if ((threadIdx.x & 63) == 0) sh[threadIdx.x >> 6] = v; __syncthreads();
    float r = 0.f; for (int i = 0; i < (int)(blockDim.x >> 6); ++i) r += sh[i]; __syncthreads(); return r;
}
__device__ __forceinline__ void dbg_report(unsigned* ctl, float err) { if (threadIdx.x == 0) atomicMax(ctl + CW_DBG, __float_as_uint(fabsf(err))); }
__global__ void dbg_fill(float* out, const unsigned* ctl) {
    const float e = __uint_as_float(ctl[CW_DBG]); const float K = 10.f * sqrtf(fminf(e, 1e4f));
    for (size_t i = (size_t)blockIdx.x * blockDim.x + threadIdx.x; i < (size_t)T * DM; i += (size_t)gridDim.x * blockDim.x) out[i] = K;
}
__global__ void dbg_check1(Args a) {
    __shared__ float sh[8];
    const unsigned s = blockIdx.x; const int row = (int)((s * 2654435761u) % (unsigned)T); const int tid = threadIdx.x;
    const float* x = a.in[0] + (size_t)row * DM; const float* g = a.in[5]; const float* w = a.in[1];
    float ss = 0.f; for (int k = tid; k < DM; k += 256) ss += x[k] * x[k];
    ss = block_sum256(ss, sh); const float rstd = rsqrtf(ss / DM + EPS);
    const bool isv = (s & 7) == 7; int n, sc;
    if (isv) { n = (int)((s * 40503u + 17u) % 512u); sc = 1024 + n; } else { n = (int)((s * 40503u + 17u) % 5416u); sc = srccol_in(n); }
    float acc = 0.f; for (int k = tid; k < DM; k += 256) acc += x[k] * rstd * g[k] * w[(size_t)k * 5928 + sc];
    acc = block_sum256(acc, sh);
    const bf16* PROJ = (const bf16*)(a.ws + WS_PROJ); const bf16* VT = (const bf16*)(a.ws + WS_VT);
    const float got = isv ? bf2f(VT[(size_t)n * T + row]) : bf2f(PROJ[(size_t)row * NPJ + n]);
    dbg_report((unsigned*)(a.ws + WS_CTL), got - acc);
}
__global__ void dbg_check9(Args a) {
    __shared__ float h2[1024], gu[2048], act[1024], ysum[1024], lg[32], gt[4], sh[8]; __shared__ int te[4];
    const unsigned s = blockIdx.x; const int t = (int)((s * 2654435761u) % (unsigned)T); const int tid = threadIdx.x;
    const float* x = a.in[0] + (size_t)t * DM;
    float ss = 0.f; for (int k = tid; k < DM; k += 256) ss += x[k] * x[k];
    ss = block_sum256(ss, sh); const float rstd = rsqrtf(ss / DM + EPS);
    for (int k = tid; k < DM; k += 256) { h2[k] = x[k] * rstd * a.in[6][k]; ysum[k] = 0.f; }
    __syncthreads();
    if (tid < 32) { float acc = 0.f; for (int k = 0; k < DM; ++k) acc += h2[k] * a.in[11][(size_t)k * 32 + tid]; lg[tid] = acc + a.in[12][tid]; }
    __syncthreads();
    if (tid == 0) { float v[32]; for (int e = 0; e < 32; ++e) v[e] = lg[e]; float tv[4];
        for (int k = 0; k < 4; ++k) { int be = 0; for (int e = 1; e < 32; ++e) if (lg[e] > lg[be]) be = e; te[k] = be; tv[k] = lg[be]; lg[be] = -INFINITY; }
        float den = 0.f; for (int k = 0; k < 4; ++k) den += expf(tv[k] - tv[0]); for (int k = 0; k < 4; ++k) gt[k] = expf(tv[k] - tv[0]) / den; (void)v; }
    __syncthreads();
    for (int k4 = 0; k4 < 4; ++k4) { const int e = te[k4];
        const float* wg = a.in[13] + (size_t)e * DM * 2048; const float* wd = a.in[15] + (size_t)e * DFF * DM;
        for (int n = tid; n < 2048; n += 256) { float acc = 0.f; for (int k = 0; k < DM; ++k) acc += h2[k] * wg[(size_t)k * 2048 + n]; gu[n] = acc + a.in[14][e * 2048 + n]; }
        __syncthreads();
        for (int j = tid; j < DFF; j += 256) { const float g = fminf(gu[j], 7.f), l = fminf(fmaxf(gu[1024 + j], -7.f), 7.f); act[j] = (l + 1.f) * g / (1.f + expf(-1.702f * g)); }
        __syncthreads();
        for (int n = tid; n < DM; n += 256) { float acc = 0.f; for (int j = 0; j < DFF; ++j) acc += act[j] * wd[(size_t)j * DM + n]; ysum[n] += gt[k4] * (acc + a.in[16][e * DM + n]); }
        __syncthreads();
    }
    float s2 = 0.f; for (int k = tid; k < DM; k += 256) { const float v = x[k] + ysum[k]; s2 += v * v; }
    s2 = block_sum256(s2, sh); const float r2 = rsqrtf(s2 / DM + EPS);
    float me = 0.f; for (int k = tid; k < DM; k += 256) { const float ref = (x[k] + ysum[k]) * r2 * a.in[7][k]; me = fmaxf(me, fabsf(a.out[(size_t)t * DM + k] - ref)); }
    atomicMax((unsigned*)(a.ws + WS_CTL) + CW_DBG, __float_as_uint(me));
}
#if DBG_STAGE == 1
#define DBG_KERNEL dbg_check1
#elif DBG_STAGE == 9
#define DBG_KERNEL dbg_check9
#endif
static void dbg_launch(Args a, hipStream_t stream) {
    hipLaunchKernelGGL(DBG_KERNEL, dim3(256), dim3(256), 0, stream, a);
    hipLaunchKernelGGL(dbg_fill, dim3(2048), dim3(256), 0, stream, a.out, (const unsigned*)(a.ws + WS_CTL));
}
#endif
#ifdef DBG_TPHASE
__global__ void dbg_tfill(float* out, const unsigned long long* ts) {
    const float us = (float)(ts[DBG_TPHASE + 1] - ts[DBG_TPHASE]) * 0.01f; const float K = 10.f * sqrtf(us * 0.001f);
    for (size_t i = (size_t)blockIdx.x * blockDim.x + threadIdx.x; i < (size_t)T * DM; i += (size_t)gridDim.x * blockDim.x) out[i] = K;
}
#endif

extern "C" void kernel_launch(void* const* d_in, const int* in_sizes, int n_in, void* d_out, int out_size, void* d_ws, size_t ws_size, hipStream_t stream) {
    static int grid = 0;
    if (grid == 0) {
        if (n_in != 17 || out_size != T * DM || ws_size < WS_END) { fprintf(stderr, "kernel_launch: unexpected shapes (n_in %d out %d ws %zu, need %zu)\n", n_in, out_size, ws_size, (size_t)WS_END); grid = -1; return; }
        int dev = 0, cus = 0, per_cu = 0;
        if (hipGetDevice(&dev) != hipSuccess || hipDeviceGetAttribute(&cus, hipDeviceAttributeMultiprocessorCount, dev) != hipSuccess) { grid = -1; return; }
        if (hipFuncSetAttribute((const void*)mk_fwd, hipFuncAttributeMaxDynamicSharedMemorySize, LDS_BYTES) != hipSuccess) { fprintf(stderr, "kernel_launch: hipFuncSetAttribute failed\n"); grid = -1; return; }
        if (hipOccupancyMaxActiveBlocksPerMultiprocessor(&per_cu, (const void*)mk_fwd, 512, LDS_BYTES) != hipSuccess || per_cu < 1) fprintf(stderr, "kernel_launch: occupancy query says %d\n", per_cu);
        (void)hipGetLastError();
        grid = cus;
    }
    if (grid < 0) return;
    (void)hipMemsetAsync((char*)d_ws + WS_CTL, 0, CTL_ZERO_BYTES, stream);
    Args a{};
    for (int i = 0; i < 17; ++i) a.in[i] = (const float*)d_in[i];
    a.out = (float*)d_out; a.ws = (unsigned char*)d_ws; a.sub = 3;
#if DBG_STAGE >= 0
    const int last = DBG_STAGE + 1;
#else
    const int last = NPHASE;
#endif
#ifdef DUP_PHASE
    { const int cuts[4] = {0, DUP_PHASE + 1, DUP_PHASE, DUP_PHASE + 1}; const int ends[3] = {DUP_PHASE + 1, DUP_PHASE + 1, NPHASE};
      for (int li = 0; li < 3; ++li) { a.ph_lo = li == 0 ? 0 : (li == 1 ? DUP_PHASE : DUP_PHASE + 1); a.ph_hi = ends[li]; (void)cuts;
          if (DUP_PHASE == 9) { if (li == 0) { a.ph_hi = 9; } else { a.ph_lo = 9; a.ph_hi = 10; } }
          if (a.ph_lo >= a.ph_hi) continue;
          a.sub = 3;
#ifdef DUP_SUB
          if (li == 1) a.sub = DUP_SUB;
#endif
          if (DUP_PHASE == 9 && li == 1) a.sub = 7;
          if (li > 0) (void)hipMemsetAsync((char*)d_ws + WS_CTL + CW_BAR * 4, 0, XCD_BAR_WORDS * 4, stream);
          if (li == 1 && DUP_PHASE == 6) (void)hipMemsetAsync((char*)d_ws + WS_CTL + CW_CNT * 4, 0, 16 * 32 * 4, stream);
          hipLaunchKernelGGL(mk_fwd, dim3(grid), dim3(512), LDS_BYTES, stream, a); } }
#else
    if (MK_N_LAUNCHES == 1) { a.ph_lo = 0; a.ph_hi = last; hipLaunchKernelGGL(mk_fwd, dim3(grid), dim3(512), LDS_BYTES, stream, a); }
    else for (int p = 0; p < last; ++p) { a.ph_lo = p; a.ph_hi = p + 1; hipLaunchKernelGGL(mk_fwd, dim3(grid), dim3(512), LDS_BYTES, stream, a); }
#endif
#if DBG_STAGE >= 0
    dbg_launch(a, stream);
#endif
#ifdef HG_PROBE_RUN
    (void)hipMemsetAsync((char*)d_ws + WS_CTL + CW_BAR * 4, 0, XCD_BAR_WORDS * 4, stream); (void)hipMemsetAsync((char*)d_ws + WS_CTL + CW_TICK * 4, 0, 8 * 64 * 4, stream);
    a.ph_lo = 3; a.ph_hi = 4; a.sub = 2 | 16; hipLaunchKernelGGL(mk_fwd, dim3(grid), dim3(512), LDS_BYTES, stream, a);
#endif
#ifdef F8_PROBE
    (void)hipMemsetAsync((char*)d_ws + WS_CTL + CW_BAR * 4, 0, XCD_BAR_WORDS * 4, stream); (void)hipMemsetAsync((char*)d_ws + WS_CTL + CW_TICK * 4, 0, 8 * 64 * 4, stream);
    a.ph_lo = 7; a.ph_hi = 8; a.sub = 3 | 8; hipLaunchKernelGGL(mk_fwd, dim3(grid), dim3(512), LDS_BYTES, stream, a);
#endif
#ifdef DBG_TPHASE
    hipLaunchKernelGGL(dbg_tfill, dim3(2048), dim3(256), 0, stream, a.out, (const unsigned long long*)((unsigned*)a.ws + 2048));
#endif
}
```
